# Optimizing an MI355X kernel written in HIP

```python
import jax, jax.numpy as jnp
from jax import lax
import numpy as np

D_MODEL = 1024
BATCH = 4
SEQ = 8192
DEPTH = 2

HG_HEADS = 4
HG_HEAD_DIM = 128
HG_WIDTH = HG_HEADS * HG_HEAD_DIM
HG_CHUNK = 64
NSA_HEADS = 8
NSA_GROUPS = 2
NSA_HEAD_DIM = 64
NSA_WIDTH = NSA_HEADS * NSA_HEAD_DIM
NSA_KV = NSA_GROUPS * NSA_HEAD_DIM
CMP_LEN = 32
CMP_STRIDE = 16
CMP_HIDDEN = 64
SEL_LEN = 64
SEL_TOPK = 16
WINDOW = 512
Q_BLOCK = 128
LRU_WIDTH = 512
LRU_BLOCKS = 4
LRU_CONV = 4
LRU_C = 8.0
FFN_DIM = 2816
FFN_CONV = 3
DEEPNORM_ALPHA = (2 * DEPTH) ** 0.25
DEEPNORM_BETA = (8 * DEPTH) ** -0.25
LN_EPS = 1e-5
N_BRANCH = 3
IN_SPLITS = (HG_WIDTH, HG_WIDTH, HG_WIDTH, HG_WIDTH,
             NSA_WIDTH, NSA_KV, NSA_KV, NSA_KV, NSA_KV, NSA_KV, NSA_KV, NSA_HEADS * 3,
             LRU_WIDTH, LRU_WIDTH,
             N_BRANCH * D_MODEL)
IN_DIM = sum(IN_SPLITS)

kernel_name = "hybrid_hgrn2_nsa_rglru_deepnorm"


def _layer_norm(x, g, b):
    xf = x.astype(jnp.float32)
    mu = jnp.mean(xf, -1, keepdims=True)
    var = jnp.mean(jnp.square(xf - mu), -1, keepdims=True)
    return ((xf - mu) * lax.rsqrt(var + LN_EPS) * g + b).astype(x.dtype)


def _split_cols(p):
    offs = [int(o) for o in np.cumsum(IN_SPLITS)[:-1]]
    return jnp.split(p, offs, axis=-1)


def _causal_dwconv(x, w, b):
    K, S = w.shape[0], x.shape[1]
    xp = jnp.pad(x, ((0, 0), (K - 1, 0), (0, 0)))
    out = b + xp[:, 0:S] * w[0]
    for j in range(1, K):
        out = out + xp[:, j:j + S] * w[j]
    return out


def _alibi_slopes(n):
    return 2.0 ** (-(8.0 / n) * jnp.arange(1, n + 1, dtype=jnp.float32))


def _masked_probs(scores, mask):
    s = jnp.where(mask, scores, -jnp.inf)
    m = jnp.max(s, axis=-1, keepdims=True)
    m = jnp.where(jnp.isfinite(m), m, 0.0)
    p = jnp.exp(s - m)
    return p / jnp.maximum(jnp.sum(p, -1, keepdims=True), 1e-30)


def _linear_combine(left, right):
    a_l, u_l = left
    a_r, u_r = right
    return a_l * a_r, a_r * u_l + u_r


def _hgrn2(q, f_logit, i, g, lb, norm_g):
    B, S, _ = q.shape
    f32 = jnp.float32
    H, d, C = HG_HEADS, HG_HEAD_DIM, HG_CHUNK
    lb = lb.astype(f32)
    fl = f_logit.astype(f32)
    log_f = jnp.log(lb + (1.0 - lb) * jax.nn.sigmoid(fl))
    k = (1.0 - lb) * jax.nn.sigmoid(-fl)

    def chunks(t):
        return t.astype(f32).reshape(B, S // C, C, H, d).transpose(1, 0, 3, 2, 4)

    xs = (chunks(q), chunks(log_f), chunks(k), chunks(i))
    causal = jnp.tril(jnp.ones((C, C), bool))[:, :, None]

    def step(state, inp):
        qc, lfc, kc, ic = inp
        b = jnp.cumsum(lfc, axis=2)
        decay = jnp.exp(jnp.where(causal, b[:, :, :, None, :] - b[:, :, None, :, :], -jnp.inf))
        attn = jnp.einsum('bhtk,bhtsk,bhsk->bhts', qc, decay, kc)
        o = attn @ ic + (qc * jnp.exp(b)) @ state
        b_last = b[:, :, -1:, :]
        state = (jnp.exp(b_last[:, :, 0, :, None]) * state
                 + jnp.swapaxes(kc * jnp.exp(b_last - b), -1, -2) @ ic)
        return state, o

    state0 = jnp.zeros((B, H, d, d), f32)
    _, o = lax.scan(step, state0, xs)
    o = o.transpose(1, 0, 3, 2, 4).reshape(B, S, H, d)
    o = o * lax.rsqrt(jnp.mean(o * o, -1, keepdims=True) + 1e-6) * norm_g.astype(f32).reshape(H, d)
    return (o.reshape(B, S, HG_WIDTH) * jax.nn.silu(g.astype(f32))).astype(q.dtype)


def _compress(t, pe, w1, w2):
    B, S, G, hd = t.shape
    tc = t.reshape(B, S // CMP_STRIDE, CMP_STRIDE, G, hd)
    blocks = jnp.concatenate([tc[:, :-1], tc[:, 1:]], axis=2) + pe[None, None, :, None, :]
    flat = blocks.transpose(0, 1, 3, 2, 4).reshape(B, -1, G, CMP_LEN * hd)
    return jax.nn.gelu(flat @ w1) @ w2


def _block_importance(p):
    R = SEL_LEN // CMP_STRIDE
    pp = jnp.pad(p, [(0, 0)] * (p.ndim - 1) + [(1, 1)])
    n_sel = (pp.shape[-1] - 1) // R
    body = pp[..., :-1].reshape(p.shape[:-1] + (n_sel, R))
    return 0.5 * body[..., 0] + jnp.sum(body[..., 1:], -1) + 0.5 * pp[..., R::R]


def _nsa(q, k_cmp, v_cmp, k_sel, v_sel, k_win, v_win, gate_logits,
         pe_k, w1_k, w2_k, pe_v, w1_v, w2_v):
    B, S, _ = q.shape
    f32 = jnp.float32
    H, G, hd = NSA_HEADS, NSA_GROUPS, NSA_HEAD_DIM
    P = H // G
    q = q.astype(f32).reshape(B, S, G, P, hd) * (hd ** -0.5)
    kv = lambda t: t.astype(f32).reshape(B, S, G, hd)
    k_cmp, v_cmp, k_sel, v_sel, k_win, v_win = (kv(t) for t in (k_cmp, v_cmp, k_sel, v_sel, k_win, v_win))
    gates = jax.nn.sigmoid(gate_logits.astype(f32)).reshape(B, S, G, P, 3)

    kc = _compress(k_cmp, pe_k, w1_k, w2_k)
    vc = _compress(v_cmp, pe_v, w1_v, w2_v)
    cmp_end = jnp.arange(kc.shape[1]) * CMP_STRIDE + (CMP_LEN - 1)
    n_sel = S // SEL_LEN
    top = min(SEL_TOPK, n_sel)
    ks_blocks = k_sel.transpose(0, 2, 1, 3).reshape(B, G, n_sel, SEL_LEN * hd)
    vs_blocks = v_sel.transpose(0, 2, 1, 3).reshape(B, G, n_sel, SEL_LEN * hd)
    kw_pad = jnp.pad(k_win, ((0, 0), (WINDOW, 0), (0, 0), (0, 0)))
    vw_pad = jnp.pad(v_win, ((0, 0), (WINDOW, 0), (0, 0), (0, 0)))
    slopes = _alibi_slopes(H).reshape(1, G, P, 1, 1)
    blk = jnp.arange(n_sel)
    in_blk = jnp.arange(SEL_LEN)
    gather = jax.vmap(jax.vmap(lambda a, idx: a[idx]))

    def block(c):
        c0 = c * Q_BLOCK
        qb = lax.dynamic_slice_in_dim(q, c0, Q_BLOCK, axis=1)
        gb = lax.dynamic_slice_in_dim(gates, c0, Q_BLOCK, axis=1)
        t = c0 + jnp.arange(Q_BLOCK)
        s = jnp.einsum('btgpd,bngd->bgptn', qb, kc)
        dist = (t[:, None] - cmp_end[None, :]).astype(f32)
        p_cmp = _masked_probs(s - slopes * dist, cmp_end[None, :] <= t[:, None])
        o_cmp = jnp.einsum('bgptn,bngd->btgpd', p_cmp, vc)
        imp = _block_importance(jnp.sum(p_cmp, axis=2))
        cur = t // SEL_LEN
        forced = (blk[None, :] == 0) | (blk[None, :] == cur[:, None]) | (blk[None, :] == cur[:, None] - 1)
        imp = jnp.where(blk[None, :] > cur[:, None], -jnp.inf, imp)
        imp = jnp.where(forced, jnp.inf, imp)
        _, idx = lax.top_k(imp, top)
        flat = idx.reshape(B, G, Q_BLOCK * top)
        ksb = gather(ks_blocks, flat).reshape(B, G, Q_BLOCK, top * SEL_LEN, hd)
        vsb = gather(vs_blocks, flat).reshape(B, G, Q_BLOCK, top * SEL_LEN, hd)
        spos = (idx[..., None] * SEL_LEN + in_blk).reshape(B, G, Q_BLOCK, top * SEL_LEN)
        s = jnp.einsum('btgpd,bgtkd->bgptk', qb, ksb)
        dist = (t[:, None] - spos[:, :, None]).astype(f32)
        p = _masked_probs(s - slopes * dist, dist >= 0)
        o_sel = jnp.einsum('bgptk,bgtkd->btgpd', p, vsb)
        kwb = lax.dynamic_slice_in_dim(kw_pad, c0, WINDOW + Q_BLOCK, axis=1)
        vwb = lax.dynamic_slice_in_dim(vw_pad, c0, WINDOW + Q_BLOCK, axis=1)
        wpos = c0 - WINDOW + jnp.arange(WINDOW + Q_BLOCK)
        wdist = t[:, None] - wpos[None, :]
        s = jnp.einsum('btgpd,bkgd->bgptk', qb, kwb)
        p = _masked_probs(s - slopes * wdist.astype(f32),
                          (wdist >= 0) & (wdist < WINDOW) & (wpos[None, :] >= 0))
        o_win = jnp.einsum('bgptk,bkgd->btgpd', p, vwb)
        return gb[..., 0:1] * o_cmp + gb[..., 1:2] * o_sel + gb[..., 2:3] * o_win

    out = lax.map(block, jnp.arange(S // Q_BLOCK))
    return out.transpose(1, 0, 2, 3, 4, 5).reshape(B, S, NSA_WIDTH).astype(gate_logits.dtype)


def _rglru(xb, yb, conv_w, conv_b, wa, ba, wx, bx, lam):
    B, S, W = xb.shape
    f32 = jnp.float32
    xc = _causal_dwconv(xb.astype(f32), conv_w.astype(f32), conv_b.astype(f32))
    xg = xc.reshape(B, S, LRU_BLOCKS, W // LRU_BLOCKS)
    r = jax.nn.sigmoid(jnp.einsum('bsgi,gij->bsgj', xg, wa.astype(f32)).reshape(B, S, W) + ba)
    i = jax.nn.sigmoid(jnp.einsum('bsgi,gij->bsgj', xg, wx.astype(f32)).reshape(B, S, W) + bx)
    log_a = -LRU_C * r * jax.nn.softplus(-lam.astype(f32))
    a = jnp.exp(log_a)
    u = jnp.sqrt(-jnp.expm1(2.0 * log_a)) * (i * xc)
    _, h = lax.associative_scan(_linear_combine, (a, u), axis=1)
    return (h * jax.nn.gelu(yb.astype(f32))).astype(yb.dtype)


def _conv_ffn(x, w_up, conv_w, conv_b, w_down):
    u, v = jnp.split(x @ w_up, 2, axis=-1)
    return (jax.nn.gelu(_causal_dwconv(u, conv_w, conv_b)) * v) @ w_down


def setup_inputs(seed: int = 0) -> dict:
    key = jax.random.key(seed)
    keys = jax.random.split(key, 40)
    cnt = iter(range(40))
    nrm = lambda shape, scale: jax.random.normal(keys[next(cnt)], shape, jnp.float32) * scale
    L, D = DEPTH, D_MODEL
    hd = NSA_HEAD_DIM
    bw = LRU_WIDTH // LRU_BLOCKS
    a0 = jax.random.uniform(keys[next(cnt)], (L, LRU_WIDTH), jnp.float32, 0.9, 0.999) ** (1.0 / LRU_C)
    return {
        "x": nrm((BATCH, SEQ, D), 1.0),
        "ln_emb_g": 1.0 + nrm((D,), 0.02),
        "ln_emb_b": nrm((D,), 0.02),
        "w_in": nrm((L, D, IN_DIM), D ** -0.5),
        "b_in": nrm((L, IN_DIM), 0.01),
        "hg_lb_logits": nrm((L, HG_WIDTH), 1.0),
        "hg_norm_g": 1.0 + nrm((L, HG_WIDTH), 0.02),
        "cmp_pe_k": nrm((L, CMP_LEN, hd), 0.1),
        "cmp_w1_k": nrm((L, CMP_LEN * hd, CMP_HIDDEN), (CMP_LEN * hd) ** -0.5),
        "cmp_w2_k": nrm((L, CMP_HIDDEN, hd), CMP_HIDDEN ** -0.5),
        "cmp_pe_v": nrm((L, CMP_LEN, hd), 0.1),
        "cmp_w1_v": nrm((L, CMP_LEN * hd, CMP_HIDDEN), (CMP_LEN * hd) ** -0.5),
        "cmp_w2_v": nrm((L, CMP_HIDDEN, hd), CMP_HIDDEN ** -0.5),
        "lru_conv_w": nrm((L, LRU_CONV, LRU_WIDTH), LRU_CONV ** -0.5),
        "lru_conv_b": nrm((L, LRU_WIDTH), 0.01),
        "lru_wa": nrm((L, LRU_BLOCKS, bw, bw), bw ** -0.5),
        "lru_ba": nrm((L, LRU_WIDTH), 0.01),
        "lru_wx": nrm((L, LRU_BLOCKS, bw, bw), bw ** -0.5),
        "lru_bx": nrm((L, LRU_WIDTH), 0.01),
        "lru_lambda": jnp.log(a0) - jnp.log1p(-a0),
        "w_branch_hg": nrm((L, HG_WIDTH, D), HG_WIDTH ** -0.5 * DEEPNORM_BETA),
        "w_branch_nsa": nrm((L, NSA_WIDTH, D), NSA_WIDTH ** -0.5 * DEEPNORM_BETA),
        "w_branch_lru": nrm((L, LRU_WIDTH, D), LRU_WIDTH ** -0.5 * DEEPNORM_BETA),
        "w_out": nrm((L, D, D), D ** -0.5 * DEEPNORM_BETA),
        "ln1_g": 1.0 + nrm((L, D), 0.02),
        "ln1_b": nrm((L, D), 0.02),
        "ffn_w_up": nrm((L, D, 2 * FFN_DIM), D ** -0.5),
        "ffn_conv_w": nrm((L, FFN_CONV, FFN_DIM), FFN_CONV ** -0.5),
        "ffn_conv_b": nrm((L, FFN_DIM), 0.01),
        "ffn_w_down": nrm((L, FFN_DIM, D), FFN_DIM ** -0.5 * DEEPNORM_BETA),
        "ln2_g": 1.0 + nrm((L, D), 0.02),
        "ln2_b": nrm((L, D), 0.02),
    }


def reference(x, ln_emb_g, ln_emb_b, w_in, b_in, hg_lb_logits, hg_norm_g,
              cmp_pe_k, cmp_w1_k, cmp_w2_k, cmp_pe_v, cmp_w1_v, cmp_w2_v,
              lru_conv_w, lru_conv_b, lru_wa, lru_ba, lru_wx, lru_bx, lru_lambda,
              w_branch_hg, w_branch_nsa, w_branch_lru, w_out, ln1_g, ln1_b,
              ffn_w_up, ffn_conv_w, ffn_conv_b, ffn_w_down, ln2_g, ln2_b):
    B, S, D = x.shape
    gam = jax.nn.softmax(hg_lb_logits.astype(jnp.float32), axis=0)
    lb_all = jnp.cumsum(gam, axis=0) - gam[0]
    x = _layer_norm(x, ln_emb_g, ln_emb_b)
    for l in range(DEPTH):
        proj = x @ w_in[l] + b_in[l]
        (hq, hf, hi, hg, nq, kc, vc, ks, vs, kw, vw, ngate, lx, ly, mgate) = _split_cols(proj)
        y_a = _hgrn2(hq, hf, hi, hg, lb_all[l], hg_norm_g[l])
        y_b = _nsa(nq, kc, vc, ks, vs, kw, vw, ngate,
                   cmp_pe_k[l], cmp_w1_k[l], cmp_w2_k[l], cmp_pe_v[l], cmp_w1_v[l], cmp_w2_v[l])
        y_c = _rglru(lx, ly, lru_conv_w[l], lru_conv_b[l], lru_wa[l], lru_ba[l],
                     lru_wx[l], lru_bx[l], lru_lambda[l])
        mg = jax.nn.sigmoid(mgate.reshape(B, S, N_BRANCH, D))
        merged = (mg[:, :, 0] * (y_a @ w_branch_hg[l])
                  + mg[:, :, 1] * (y_b @ w_branch_nsa[l])
                  + mg[:, :, 2] * (y_c @ w_branch_lru[l]))
        x = _layer_norm(DEEPNORM_ALPHA * x + merged @ w_out[l], ln1_g[l], ln1_b[l])
        x = _layer_norm(DEEPNORM_ALPHA * x + _conv_ffn(x, ffn_w_up[l], ffn_conv_w[l], ffn_conv_b[l], ffn_w_down[l]),
                        ln2_g[l], ln2_b[l])
    return x
```

```cpp
#include <hip/hip_runtime.h>
#include <hip/hip_cooperative_groups.h>
#include <cstdio>
namespace cg = cooperative_groups;

#ifndef MULTI_LAUNCH
#define MULTI_LAUNCH 0
#endif

#define DI __device__ __forceinline__
typedef unsigned short u16;
typedef unsigned int u32;
typedef unsigned long long u64;
typedef __attribute__((ext_vector_type(8))) short bf16x8;
typedef __attribute__((ext_vector_type(4))) short bf16x4;
typedef __attribute__((ext_vector_type(16))) float f32x16;
typedef __attribute__((ext_vector_type(2))) __bf16 bf2_t;

#define MFMA32(a, b, c) __builtin_amdgcn_mfma_f32_32x32x16_bf16((a), (b), (c), 0, 0, 0)

constexpr int NTOK = 32768, SEQ = 8192, PW = 4480, INDIM = 7448, FF = 2816;
constexpr int C_HQ = 0, C_HF = 512, C_HI = 1024, C_HG = 1536, C_NQ = 2048, C_KC = 2560, C_VC = 2688,
              C_KS = 2816, C_VS = 2944, C_KW = 3072, C_VW = 3200, C_NG = 3328, C_LX = 3352, C_LY = 3864, C_MG = 4376;
constexpr size_t OFF_XB = 0;
constexpr size_t OFF_R1 = 67108864;
constexpr size_t OFF_HS = OFF_R1 + 293601280;
constexpr size_t OFF_VST = OFF_HS + 67108864;
constexpr size_t OFF_W = OFF_R1 + 369098752;
constexpr size_t OFF_VWT = OFF_W + 38060032;
constexpr size_t OFF_DEC = OFF_VWT + 8388608;
constexpr size_t OFF_KCG = OFF_DEC + 1048576;
constexpr size_t OFF_VCT = OFF_KCG + 524288;
constexpr size_t OFF_CARA = OFF_VCT + 524288;
constexpr size_t OFF_CARH = OFF_CARA + 2097152;
constexpr size_t OFF_CARI = OFF_CARH + 2097152;
constexpr size_t OFF_BAR = OFF_CARI + 2097152;
constexpr size_t OFF_HALO = OFF_BAR + 4096;
constexpr size_t OFF_W1F = OFF_HALO + 2097152;
constexpr size_t OFF_PEV = OFF_W1F + 524288;
constexpr int W_IN = 0, W_BR = 7626752, W_OUT = 9199616, W_UP = 10248192, W_DOWN = 16015360, W_LA = 18898944, W_LX = 18964480;
constexpr int N_CONV_TILES = 1872 + 384 + 256 + 1408 + 704 + 32 + 64 + 2;
constexpr int NPHASE = 23;
constexpr float ALPHA = 1.41421356237f;
constexpr int SMEM_BYTES = 147456;

struct Params {
  const float* in[32];
  float* xf;
  char* ws;
  int ph_lo, ph_hi;
};
template <class T> DI T* as_global(T* q) { return (T*)(__attribute__((address_space(1))) T*)q; }
struct Ctx {
  const Params& kp;
  float* xf;
  char* ws;
  int tid;
  int tid8;
};

DI u32 pk2(float a, float b) { bf2_t v; v[0] = (__bf16)a; v[1] = (__bf16)b; return __builtin_bit_cast(u32, v); }
DI u16 f2bf(float a) { __bf16 v = (__bf16)a; return __builtin_bit_cast(u16, v); }
DI float bf2f(u16 v) { return __uint_as_float(((u32)v) << 16); }
DI float bflo(u32 v) { return __uint_as_float(v << 16); }
DI float bfhi(u32 v) { return __uint_as_float(v & 0xffff0000u); }
DI int crow(int reg, int h) { return (reg & 3) + 8 * (reg >> 2) + 4 * h; }
DI f32x16 zero16() { f32x16 z;
#pragma unroll
  for (int i = 0; i < 16; ++i) z[i] = 0.f; return z; }
template <int S> DI bf16x8 pack8(const f32x16& x) {
  uint4 u;
  u.x = pk2(x[8 * S + 0], x[8 * S + 1]); u.y = pk2(x[8 * S + 2], x[8 * S + 3]);
  u.z = pk2(x[8 * S + 4], x[8 * S + 5]); u.w = pk2(x[8 * S + 6], x[8 * S + 7]);
  return __builtin_bit_cast(bf16x8, u);
}
DI bf16x8 cat4(bf16x4 lo, bf16x4 hi) { return __builtin_shufflevector(lo, hi, 0, 1, 2, 3, 4, 5, 6, 7); }
DI float wave_sum(float v) {
#pragma unroll
  for (int o = 32; o > 0; o >>= 1) v += __shfl_xor(v, o);
  return v;
}
DI float frcp(float x) { return __builtin_amdgcn_rcpf(x); }
DI float sigmoidf_(float x) { return frcp(1.f + __expf(-x)); }
DI float gelu_t(float x) {
  float z = 0.7978845608028654f * (x + 0.044715f * x * x * x);
  float e = __expf(2.f * z);
  float th = 1.f - 2.f * frcp(e + 1.f);
  return 0.5f * x * (1.f + th);
}

DI u16* ws_xb(const Ctx& p) { return (u16*)(p.ws + OFF_XB); }
DI u16* ws_P(const Ctx& p) { return (u16*)(p.ws + OFF_R1); }
DI u16* ws_HS(const Ctx& p) { return (u16*)(p.ws + OFF_HS); }
DI u16* ws_W(const Ctx& p) { return (u16*)(p.ws + OFF_W); }

DI void convT_tile(const Ctx& p, const float* __restrict__ src, int K, int N, u16* __restrict__ dst, int tile, char* smem) {
  float* t = (float*)smem;
  int ntn = (N + 63) >> 6;
  int kt = tile / ntn, nt = tile - kt * ntn;
  int k0 = kt * 64, n0 = nt * 64;
  int tid = p.tid, c = tid & 63, r4 = tid >> 6;
  __syncthreads();
  float ld[16];
#pragma unroll
  for (int i = 0; i < 16; ++i) {
    int r = r4 + 4 * i; int n = n0 + c;
    ld[i] = (n < N) ? src[(size_t)(k0 + r) * N + n] : 0.f;
  }
#pragma unroll
  for (int i = 0; i < 16; ++i) t[(r4 + 4 * i) * 65 + c] = ld[i];
  __syncthreads();
  const int c4 = tid & 15, rr = tid >> 4;
#pragma unroll
  for (int i = 0; i < 4; ++i) {
    int r = rr + 16 * i; int n = n0 + r;
    uint2 o;
    o.x = pk2(t[(4 * c4 + 0) * 65 + r], t[(4 * c4 + 1) * 65 + r]);
    o.y = pk2(t[(4 * c4 + 2) * 65 + r], t[(4 * c4 + 3) * 65 + r]);
    if (n < N) *(uint2*)(dst + (size_t)n * K + k0 + 4 * c4) = o;
  }
}
DI void conv_item(const Ctx& p, int l, int idx, char* smem) {
  u16* W = ws_W(p);
  if (idx < 1872) { convT_tile(p, p.kp.in[3] + (size_t)l * 1024 * INDIM, 1024, INDIM, W + W_IN, idx, smem); return; }
  idx -= 1872;
  if (idx < 384) { int br = idx >> 7; convT_tile(p, p.kp.in[20 + br] + (size_t)l * 512 * 1024, 512, 1024, W + W_BR + br * 524288, idx & 127, smem); return; }
  idx -= 384;
  if (idx < 256) { convT_tile(p, p.kp.in[23] + (size_t)l * 1024 * 1024, 1024, 1024, W + W_OUT, idx, smem); return; }
  idx -= 256;
  if (idx < 1408) { convT_tile(p, p.kp.in[26] + (size_t)l * 1024 * 5632, 1024, 5632, W + W_UP, idx, smem); return; }
  idx -= 1408;
  if (idx < 704) { convT_tile(p, p.kp.in[29] + (size_t)l * FF * 1024, FF, 1024, W + W_DOWN, idx, smem); return; }
  idx -= 704;
  if (idx < 32) {
    int which = idx >> 4, g = (idx >> 2) & 3, tl = idx & 3;
    convT_tile(p, p.kp.in[which ? 17 : 15] + (size_t)(l * 4 + g) * 16384, 128, 128, W + (which ? W_LX : W_LA) + g * 16384, tl, smem);
    return;
  }
  idx -= 32;
  if (idx < 64) {
    const int kv = idx >> 5, part = idx & 31;
    const float* w1 = p.kp.in[kv ? 11 : 8] + (size_t)l * 2048 * 64;
    u16* dst = (u16*)(p.ws + OFF_W1F) + (size_t)kv * 131072;
    __syncthreads();
    const int j = p.tid & 63;
#pragma unroll 4
    for (int i = 0; i < 16; ++i) {
      const int k = part * 64 + (p.tid >> 6) + 4 * i;
      const float v = w1[(size_t)k * 64 + j];
      dst[(((j >> 5) * 128 + (k >> 4)) * 64 + (j & 31) + 32 * ((k >> 3) & 1)) * 8 + (k & 7)] = f2bf(v);
    }
    __syncthreads();
    return;
  }
  idx -= 64;
  {
    const int kv = idx;
    const float* w1 = p.kp.in[kv ? 11 : 8] + (size_t)l * 2048 * 64;
    const float* pe = p.kp.in[kv ? 10 : 7] + (size_t)l * 2048;
    float* red = (float*)smem;
    const int j = p.tid & 63, ks = p.tid >> 6;
    float a = 0.f;
#pragma unroll 8
    for (int k = ks * 512; k < ks * 512 + 512; ++k) a += pe[k] * w1[(size_t)k * 64 + j];
    __syncthreads();
    red[ks * 64 + j] = a;
    __syncthreads();
    if (p.tid < 64) ((float*)(p.ws + OFF_PEV))[kv * 64 + p.tid] = red[p.tid] + red[64 + p.tid] + red[128 + p.tid] + red[192 + p.tid];
  }
}

DI void ln_rows(const Ctx& p, const float* src, float* dstf, u16* dstb, const float* __restrict__ g, const float* __restrict__ bta, int item) {
  const int w = p.tid >> 6, l = p.tid & 63;
  const size_t row0 = (size_t)item * 8 + w, row1 = row0 + 4;
  const float4* sa = (const float4*)(src + row0 * 1024);
  const float4* sb = (const float4*)(src + row1 * 1024);
  float4 va[4], vb[4]; float suma = 0.f, sumb = 0.f;
#pragma unroll
  for (int i = 0; i < 4; ++i) { va[i] = sa[l + 64 * i]; vb[i] = sb[l + 64 * i]; }
#pragma unroll
  for (int i = 0; i < 4; ++i) { suma += va[i].x + va[i].y + va[i].z + va[i].w; sumb += vb[i].x + vb[i].y + vb[i].z + vb[i].w; }
  suma = wave_sum(suma); sumb = wave_sum(sumb);
  const float mua = suma * (1.f / 1024.f), mub = sumb * (1.f / 1024.f);
  float vsa = 0.f, vsb = 0.f;
#pragma unroll
  for (int i = 0; i < 4; ++i) {
    float a = va[i].x - mua, b = va[i].y - mua, c = va[i].z - mua, d = va[i].w - mua;
    vsa += a * a + b * b + c * c + d * d;
    float e = vb[i].x - mub, f = vb[i].y - mub, gg = vb[i].z - mub, hh = vb[i].w - mub;
    vsb += e * e + f * f + gg * gg + hh * hh;
  }
  vsa = wave_sum(vsa); vsb = wave_sum(vsb);
  const float rsa = rsqrtf(vsa * (1.f / 1024.f) + 1e-5f), rsb = rsqrtf(vsb * (1.f / 1024.f) + 1e-5f);
#pragma unroll
  for (int i = 0; i < 4; ++i) {
    const int ci = l + 64 * i;
    const float4 gv = ((const float4*)g)[ci], bv = ((const float4*)bta)[ci];
    float4 o;
    o.x = (va[i].x - mua) * rsa * gv.x + bv.x; o.y = (va[i].y - mua) * rsa * gv.y + bv.y;
    o.z = (va[i].z - mua) * rsa * gv.z + bv.z; o.w = (va[i].w - mua) * rsa * gv.w + bv.w;
    ((float4*)(dstf + row0 * 1024))[ci] = o;
    uint2 pk; pk.x = pk2(o.x, o.y); pk.y = pk2(o.z, o.w);
    ((uint2*)(dstb + row0 * 1024))[ci] = pk;
    o.x = (vb[i].x - mub) * rsb * gv.x + bv.x; o.y = (vb[i].y - mub) * rsb * gv.y + bv.y;
    o.z = (vb[i].z - mub) * rsb * gv.z + bv.z; o.w = (vb[i].w - mub) * rsb * gv.w + bv.w;
    ((float4*)(dstf + row1 * 1024))[ci] = o;
    pk.x = pk2(o.x, o.y); pk.y = pk2(o.z, o.w);
    ((uint2*)(dstb + row1 * 1024))[ci] = pk;
  }
}

struct GStage { uint4 w0, w1, w2, w3, x0, x1, x2, x3; };
struct GOp { const u16* W; const u16* X; int ldw, ldx, K; unsigned wr1, wr2, wr3; };
DI void op_rows(GOp& o) { o.wr1 = 128u * (unsigned)o.ldw; o.wr2 = 2u * o.wr1; o.wr3 = 3u * o.wr1; }

template <int NI, int MI>
DI void gemm8(const Ctx& p, const GOp& op, const GOp& nx, bool has_next, bool primed, GStage& g, f32x16 (&acc)[NI][MI], char* smem) {
  constexpr int WR = NI * 64, XR = MI * 128, STG = (WR + XR) * 72;
  u16* sW = (u16*)smem;
  u16* sX = sW + WR * 72;
  const int tid = p.tid8, l = tid & 63, w = tid >> 6;
  const int wn = w & 1, wm = w >> 1, r = l & 31, h = l >> 5;
  const int lr = tid >> 3, lc = tid & 7;
#define G_LOAD(O, ko)                                                                      \
  {                                                                                        \
      \
    const char* wb_ = (const char*)(O).W; const char* xb_ = (const char*)(O).X;            \
    const unsigned wo_ = ((unsigned)lr * (unsigned)(O).ldw + (unsigned)(lc * 8 + (ko))) * 2u; \
    const unsigned xo_ = ((unsigned)lr * (unsigned)(O).ldx + (unsigned)(lc * 8 + (ko))) * 2u; \
    const unsigned xs_ = 128u * (unsigned)(O).ldx;                                         \
    g.w0 = *(const uint4*)(wb_ + wo_);                                                     \
    g.w1 = *(const uint4*)(wb_ + (wo_ + (O).wr1));                                         \
    if (NI == 4) {                                                                         \
      g.w2 = *(const uint4*)(wb_ + (wo_ + (O).wr2));                                       \
      g.w3 = *(const uint4*)(wb_ + (wo_ + (O).wr3));                                       \
    }                                                                                      \
    g.x0 = *(const uint4*)(xb_ + xo_);                                                     \
    g.x1 = *(const uint4*)(xb_ + (xo_ + xs_));                                             \
    if (MI == 2) {                                                                         \
      g.x2 = *(const uint4*)(xb_ + (xo_ + 2u * xs_));                                      \
      g.x3 = *(const uint4*)(xb_ + (xo_ + 3u * xs_));                                      \
    }                                                                                      \
  }
#define G_STORE(st)                                                    \
  {                                                                    \
    u16* bw_ = sW + (st) * STG; u16* bx_ = sX + (st) * STG;            \
    *(uint4*)(bw_ + (lr) * 72 + lc * 8) = g.w0;                        \
    *(uint4*)(bw_ + (lr + 64) * 72 + lc * 8) = g.w1;                   \
    if (NI == 4) {                                                     \
      *(uint4*)(bw_ + (lr + 128) * 72 + lc * 8) = g.w2;                \
      *(uint4*)(bw_ + (lr + 192) * 72 + lc * 8) = g.w3;                \
    }                                                                  \
    *(uint4*)(bx_ + (lr) * 72 + lc * 8) = g.x0;                        \
    *(uint4*)(bx_ + (lr + 64) * 72 + lc * 8) = g.x1;                   \
    if (MI == 2) {                                                     \
      *(uint4*)(bx_ + (lr + 128) * 72 + lc * 8) = g.x2;                \
      *(uint4*)(bx_ + (lr + 192) * 72 + lc * 8) = g.x3;                \
    }                                                                  \
  }
  if (!primed) {
    G_LOAD(op, 0)
    __syncthreads();
    G_STORE(0)
    G_LOAD(op, 64)
    __syncthreads();
  }
  const int KT = op.K >> 6;
#pragma unroll 1
  for (int kt = 0; kt < KT; ++kt) {
    const int cur = kt & 1;
    if (kt + 1 < KT || has_next) { G_STORE(cur ^ 1) }
    if (kt + 2 < KT) { G_LOAD(op, (kt + 2) * 64) }
    else if (has_next) { G_LOAD(nx, (kt + 2 - KT) * 64) }
    const u16* cw = sW + cur * STG + (wn * (NI * 32) + r) * 72 + h * 8;
    const u16* cx = sX + cur * STG + (wm * (MI * 32) + r) * 72 + h * 8;
    bf16x8 fa0[NI], fb0[MI], fa1[NI], fb1[MI];
#define F_LOAD(FA, FB, ks)                                                                         \
  _Pragma("unroll") for (int ni = 0; ni < NI; ++ni) FA[ni] = *(const bf16x8*)(cw + ni * 32 * 72 + (ks) * 16); \
  _Pragma("unroll") for (int mi = 0; mi < MI; ++mi) FB[mi] = *(const bf16x8*)(cx + mi * 32 * 72 + (ks) * 16);
#define F_MMA(FA, FB)                                                                              \
  _Pragma("unroll") for (int ni = 0; ni < NI; ++ni)                                                \
  _Pragma("unroll") for (int mi = 0; mi < MI; ++mi) acc[ni][mi] = MFMA32(FA[ni], FB[mi], acc[ni][mi]);
    F_LOAD(fa0, fb0, 0)
    F_LOAD(fa1, fb1, 1)
    __builtin_amdgcn_sched_barrier(0);
    F_MMA(fa0, fb0)
    __builtin_amdgcn_sched_barrier(0);
    F_LOAD(fa0, fb0, 2)
    __builtin_amdgcn_sched_barrier(0);
    F_MMA(fa1, fb1)
    __builtin_amdgcn_sched_barrier(0);
    F_LOAD(fa1, fb1, 3)
    __builtin_amdgcn_sched_barrier(0);
    F_MMA(fa0, fb0)
    __builtin_amdgcn_sched_barrier(0);
    F_MMA(fa1, fb1)
#undef F_LOAD
#undef F_MMA
    __syncthreads();
  }
#undef G_LOAD
#undef G_STORE
}

#define EPI_GEOM(NI_, MI_)                                                              \
  const int l_ = p.tid8 & 63, w_ = p.tid8 >> 6;                                         \
  const int nb_ = (w_ & 1) * (NI_ * 32) + 4 * (l_ >> 5), mb_ = (w_ >> 1) * (MI_ * 32) + (l_ & 31);

template <bool BIAS>
DI void epi_rows_bf16(const Ctx& p, f32x16 (&acc)[4][2], const float* bias_n0, u16* out_m0n0, unsigned ldo, int nvalid, char* smem) {
  const int l_ = p.tid8 & 63, w_ = p.tid8 >> 6, r_ = l_ & 31, h_ = l_ >> 5;
  const int wn_ = w_ & 1, wm_ = w_ >> 1;
  u16* sl = (u16*)(smem + 73728 + w_ * 9216);
#pragma unroll
  for (int half = 0; half < 2; ++half) {
#pragma unroll
    for (int ni2 = 0; ni2 < 2; ++ni2) {
      const int ni = 2 * half + ni2;
#pragma unroll
      for (int gq = 0; gq < 4; ++gq) {
        float4 bv = make_float4(0.f, 0.f, 0.f, 0.f);
        if (BIAS) bv = *(const float4*)(bias_n0 + wn_ * 128 + ni * 32 + 8 * gq + 4 * h_);
#pragma unroll
        for (int mi = 0; mi < 2; ++mi) {
          uint2 o;
          o.x = pk2(acc[ni][mi][4 * gq + 0] + bv.x, acc[ni][mi][4 * gq + 1] + bv.y);
          o.y = pk2(acc[ni][mi][4 * gq + 2] + bv.z, acc[ni][mi][4 * gq + 3] + bv.w);
          *(uint2*)(sl + (mi * 32 + r_) * 72 + ni2 * 32 + 8 * gq + 4 * h_) = o;
        }
      }
    }
#pragma unroll
    for (int i = 0; i < 8; ++i) {
      const int row = (l_ >> 3) + 8 * i, ch = l_ & 7;
      uint4 v = *(const uint4*)(sl + row * 72 + ch * 8);
      const int n = wn_ * 128 + half * 64 + ch * 8;
      if (n < nvalid) *(uint4*)((char*)out_m0n0 + ((unsigned)(wm_ * 64 + row) * ldo + (unsigned)n) * 2u) = v;
    }
  }
  __syncthreads();
}

DI GOp op_inproj(const Ctx& p, int mt, int nt) { GOp o; o.W = ws_W(p) + W_IN + (size_t)(nt * 256) * 1024; o.X = ws_xb(p) + (size_t)(mt * 256) * 1024; o.ldw = 1024; o.ldx = 1024; o.K = 1024; op_rows(o); return o; }
DI void ph_inproj(const Ctx& p, int l, int mt, int nt, int mtn, int ntn, bool has_next, bool primed, GStage& g, char* smem) {
  const int n0 = nt * 256, m0 = mt * 256;
  f32x16 acc[4][2];
#pragma unroll
  for (int i = 0; i < 4; ++i)
#pragma unroll
    for (int j = 0; j < 2; ++j) acc[i][j] = zero16();
  gemm8<4, 2>(p, op_inproj(p, mt, nt), op_inproj(p, mtn, ntn), has_next, primed, g, acc, smem);
  const float* bias = p.kp.in[4] + (size_t)l * INDIM;
  epi_rows_bf16<true>(p, acc, bias + n0, ws_P(p) + (size_t)m0 * PW + n0, PW, PW - n0, smem);
}

DI GOp op_merge(const Ctx& p, int mt, int nt, int sq) {
  const int br = sq >> 1; GOp o;
  if ((sq & 1) == 0) { o.W = ws_W(p) + W_IN + (size_t)(C_MG + br * 1024 + nt * 128) * 1024; o.X = ws_xb(p) + (size_t)(mt * 256) * 1024; o.ldw = 1024; o.ldx = 1024; o.K = 1024; }
  else { o.W = ws_W(p) + W_BR + br * 524288 + (size_t)(nt * 128) * 512; o.X = ws_P(p) + (size_t)(mt * 256) * PW + (br == 0 ? C_HQ : (br == 1 ? C_NQ : C_LY)); o.ldw = 512; o.ldx = PW; o.K = 512; }
  op_rows(o);
  return o;
}
DI void ph_merge(const Ctx& p, int l, int mt, int nt, int mtn, int ntn, bool has_next, bool primed, GStage& g, char* smem) {
  const int n0 = nt * 128, m0 = mt * 256;
  const u16* P = ws_P(p);
  u16* M = ws_HS(p);
  EPI_GEOM(2, 2)
#pragma unroll 1
  for (int br = 0; br < 3; ++br) {
    f32x16 ga[2][2];
#pragma unroll
    for (int i = 0; i < 2; ++i)
#pragma unroll
      for (int j = 0; j < 2; ++j) ga[i][j] = zero16();
    gemm8<2, 2>(p, op_merge(p, mt, nt, 2 * br), op_merge(p, mt, nt, 2 * br + 1), true, primed || br > 0, g, ga, smem);
    const float* bias = p.kp.in[4] + (size_t)l * INDIM + C_MG + br * 1024;
    u32 sg0[2][8];
    uint4* sgl = (uint4*)(smem + 110592 + w_ * 4096) + l_;
#pragma unroll
    for (int ni = 0; ni < 2; ++ni) {
      u32 sv[2][8];
#pragma unroll
      for (int gq = 0; gq < 4; ++gq) {
        float4 bv = *(const float4*)(bias + n0 + nb_ + ni * 32 + 8 * gq);
#pragma unroll
        for (int mi = 0; mi < 2; ++mi) {
          sv[mi][2 * gq + 0] = pk2(sigmoidf_(ga[ni][mi][4 * gq + 0] + bv.x), sigmoidf_(ga[ni][mi][4 * gq + 1] + bv.y));
          sv[mi][2 * gq + 1] = pk2(sigmoidf_(ga[ni][mi][4 * gq + 2] + bv.z), sigmoidf_(ga[ni][mi][4 * gq + 3] + bv.w));
        }
      }
      if (ni == 0) {
#pragma unroll
        for (int mi = 0; mi < 2; ++mi)
#pragma unroll
          for (int e = 0; e < 8; ++e) sg0[mi][e] = sv[mi][e];
      } else {
#pragma unroll
        for (int mi = 0; mi < 2; ++mi)
#pragma unroll
          for (int q = 0; q < 2; ++q) sgl[(mi * 2 + q) * 64] = make_uint4(sv[mi][4 * q], sv[mi][4 * q + 1], sv[mi][4 * q + 2], sv[mi][4 * q + 3]);
      }
    }
#pragma unroll
    for (int i = 0; i < 2; ++i)
#pragma unroll
      for (int j = 0; j < 2; ++j) ga[i][j] = zero16();
    gemm8<2, 2>(p, op_merge(p, mt, nt, 2 * br + 1), (br < 2) ? op_merge(p, mt, nt, 2 * br + 2) : op_merge(p, mtn, ntn, 0), (br < 2) || has_next, true, g, ga, smem);
    {
      int ll = l_;
      asm volatile("" : "+v"(ll));
      u16* sl = (u16*)(smem + 55296 + w_ * 5120);
      const int r_ = ll & 31, h_ = ll >> 5, wn_ = w_ & 1, wm_ = w_ >> 1;
#pragma unroll
      for (int ni = 0; ni < 2; ++ni) {
        u32 sv[2][8];
#pragma unroll
        for (int mi = 0; mi < 2; ++mi) {
          if (ni == 0) {
#pragma unroll
            for (int e = 0; e < 8; ++e) sv[mi][e] = sg0[mi][e];
          } else {
#pragma unroll
            for (int q = 0; q < 2; ++q) {
              const uint4 t4 = sgl[(mi * 2 + q) * 64];
              sv[mi][4 * q] = t4.x; sv[mi][4 * q + 1] = t4.y; sv[mi][4 * q + 2] = t4.z; sv[mi][4 * q + 3] = t4.w;
            }
          }
        }
#pragma unroll
        for (int mi = 0; mi < 2; ++mi)
#pragma unroll
          for (int gq = 0; gq < 4; ++gq) {
            uint2 o;
            o.x = pk2(bflo(sv[mi][2 * gq]) * ga[ni][mi][4 * gq + 0], bfhi(sv[mi][2 * gq]) * ga[ni][mi][4 * gq + 1]);
            o.y = pk2(bflo(sv[mi][2 * gq + 1]) * ga[ni][mi][4 * gq + 2], bfhi(sv[mi][2 * gq + 1]) * ga[ni][mi][4 * gq + 3]);
            *(uint2*)(sl + (mi * 32 + r_) * 40 + 8 * gq + 4 * h_) = o;
          }
        uint4 vv[4], pv[4];
#pragma unroll
        for (int i = 0; i < 4; ++i) {
          const int row = (ll >> 2) + 16 * i, ch = ll & 3;
          vv[i] = *(const uint4*)(sl + row * 40 + ch * 8);
          pv[i] = make_uint4(0, 0, 0, 0);
          if (br > 0) pv[i] = *(const uint4*)((const char*)M + (((unsigned)(m0 + wm_ * 64 + row)) * 1024u + (unsigned)(n0 + wn_ * 64 + ni * 32 + ch * 8)) * 2u);
        }
#pragma unroll
        for (int i = 0; i < 4; ++i) {
          const int row = (ll >> 2) + 16 * i, ch = ll & 3;
          uint4 v = vv[i];
          if (br > 0) {
            v.x = pk2(bflo(pv[i].x) + bflo(v.x), bfhi(pv[i].x) + bfhi(v.x)); v.y = pk2(bflo(pv[i].y) + bflo(v.y), bfhi(pv[i].y) + bfhi(v.y));
            v.z = pk2(bflo(pv[i].z) + bflo(v.z), bfhi(pv[i].z) + bfhi(v.z)); v.w = pk2(bflo(pv[i].w) + bflo(v.w), bfhi(pv[i].w) + bfhi(v.w));
          }
          *(uint4*)((char*)M + (((unsigned)(m0 + wm_ * 64 + row)) * 1024u + (unsigned)(n0 + wn_ * 64 + ni * 32 + ch * 8)) * 2u) = v;
        }
      }
      __syncthreads();
    }
  }
}

DI GOp op_resid(const u16* Wt, int ldw, const u16* X, int ldx, int K, int mt, int nt) { GOp o; o.W = Wt + (size_t)(nt * 256) * ldw; o.X = X + (size_t)(mt * 256) * ldx; o.ldw = ldw; o.ldx = ldx; o.K = K; op_rows(o); return o; }
DI void ph_resid_gemm(const Ctx& p, const u16* Wt, int ldw, const u16* X, int ldx, int K, int mt, int nt, int mtn, int ntn, bool has_next, bool primed, GStage& g, char* smem) {
  const int n0 = nt * 256, m0 = mt * 256;
  f32x16 acc[4][2];
#pragma unroll
  for (int i = 0; i < 4; ++i)
#pragma unroll
    for (int j = 0; j < 2; ++j) acc[i][j] = zero16();
  gemm8<4, 2>(p, op_resid(Wt, ldw, X, ldx, K, mt, nt), op_resid(Wt, ldw, X, ldx, K, mtn, ntn), has_next, primed, g, acc, smem);
  {
    const int l_ = p.tid8 & 63, w_ = p.tid8 >> 6, r_ = l_ & 31, h_ = l_ >> 5, wn_ = w_ & 1, wm_ = w_ >> 1;
    float* sl = (float*)(smem + 73728 + w_ * 9216);
    char* xb = (char*)p.xf;
#pragma unroll
    for (int ni = 0; ni < 4; ++ni) {
#pragma unroll
      for (int mi = 0; mi < 2; ++mi)
#pragma unroll
        for (int gq = 0; gq < 4; ++gq)
          *(float4*)(sl + (mi * 32 + r_) * 36 + 8 * gq + 4 * h_) =
              make_float4(acc[ni][mi][4 * gq + 0], acc[ni][mi][4 * gq + 1], acc[ni][mi][4 * gq + 2], acc[ni][mi][4 * gq + 3]);
#pragma unroll
      for (int i4 = 0; i4 < 8; i4 += 4) {
        float4 xs[4], vs[4];
#pragma unroll
        for (int i = 0; i < 4; ++i) {
          const int row = (l_ >> 3) + 8 * (i4 + i), ch = l_ & 7;
          vs[i] = *(const float4*)(sl + row * 36 + ch * 4);
          xs[i] = *(const float4*)(xb + (((unsigned)(m0 + wm_ * 64 + row)) * 1024u + (unsigned)(n0 + wn_ * 128 + ni * 32 + ch * 4)) * 4u);
        }
#pragma unroll
        for (int i = 0; i < 4; ++i) {
          const int row = (l_ >> 3) + 8 * (i4 + i), ch = l_ & 7;
          float4 x = xs[i];
          x.x = ALPHA * x.x + vs[i].x; x.y = ALPHA * x.y + vs[i].y; x.z = ALPHA * x.z + vs[i].z; x.w = ALPHA * x.w + vs[i].w;
          *(float4*)(xb + (((unsigned)(m0 + wm_ * 64 + row)) * 1024u + (unsigned)(n0 + wn_ * 128 + ni * 32 + ch * 4)) * 4u) = x;
        }
      }
    }
    __syncthreads();
  }
}

DI GOp op_ffnup(const Ctx& p, int mt, int nt) {
  GOp o; o.W = ws_W(p) + W_UP + (size_t)(nt * 128) * 1024; o.X = ws_xb(p) + (size_t)(mt * 256) * 1024; o.ldw = 1024; o.ldx = 1024; o.K = 1024;
  o.wr1 = (unsigned)FF * 2048u; o.wr2 = 64u * 2048u; o.wr3 = (unsigned)(FF + 64) * 2048u;
  return o;
}
DI void ph_ffnup(const Ctx& p, int l, int mt, int nt, int mtn, int ntn, bool has_next, bool primed, GStage& g, char* smem) {
  const int c0 = nt * 128, m0 = mt * 256;
  f32x16 acc[4][2];
#pragma unroll
  for (int i = 0; i < 4; ++i)
#pragma unroll
    for (int j = 0; j < 2; ++j) acc[i][j] = zero16();
  gemm8<4, 2>(p, op_ffnup(p, mt, nt), op_ffnup(p, mt, nt), false, false, g, acc, smem);
  const int l_ = p.tid8 & 63, w_ = p.tid8 >> 6, r_ = l_ & 31, h_ = l_ >> 5, wn_ = w_ & 1, wm_ = w_ >> 1;
  u16* sl = (u16*)(smem + 73728 + w_ * 9216);
  u16* sh = (u16*)(smem + w_ * 9216);
#pragma unroll
  for (int ni = 0; ni < 2; ++ni)
#pragma unroll
    for (int mi = 0; mi < 2; ++mi)
#pragma unroll
      for (int gq = 0; gq < 4; ++gq) {
        uint2 o; o.x = pk2(acc[ni][mi][4 * gq + 0], acc[ni][mi][4 * gq + 1]); o.y = pk2(acc[ni][mi][4 * gq + 2], acc[ni][mi][4 * gq + 3]);
        *(uint2*)(sl + (mi * 32 + r_) * 72 + ni * 32 + 8 * gq + 4 * h_) = o;
      }
  __syncthreads();
  const float* cw = p.kp.in[27] + (size_t)l * 3 * FF;
  const float* cb = p.kp.in[28] + (size_t)l * FF;
  const u16* halo = (const u16*)(p.ws + OFF_HALO) + (size_t)(2 * mt) * FF;
  const bool seq_start = (m0 & (SEQ - 1)) == 0;
  const u16* prv = sl - 2 * 4608;
#pragma unroll
  for (int ni = 0; ni < 2; ++ni)
#pragma unroll
    for (int gq = 0; gq < 4; ++gq) {
      const int cl = ni * 32 + 8 * gq + 4 * h_;
      int cg = c0 + wn_ * 64 + cl;
      asm volatile("" : "+v"(cg));
      const float4 w0 = *(const float4*)(cw + cg), w1 = *(const float4*)(cw + FF + cg), w2 = *(const float4*)(cw + 2 * FF + cg);
      const float4 b4 = *(const float4*)(cb + cg);
#pragma unroll
      for (int mi = 0; mi < 2; ++mi) {
        const int tokl = mi * 32 + r_;
        uint2 um1, um2;
        if (mi == 1) {
          um1 = *(const uint2*)(sl + (tokl - 1) * 72 + cl);
          um2 = *(const uint2*)(sl + (tokl - 2) * 72 + cl);
        } else {
          const u16* p1 = (tokl >= 1) ? sl + (tokl - 1) * 72 : prv + 63 * 72;
          const u16* p2 = (tokl >= 2) ? sl + (tokl - 2) * 72 : prv + (62 + tokl) * 72;
          um1 = *(const uint2*)(p1 + cl);
          um2 = *(const uint2*)(p2 + cl);
          if (wm_ == 0) {
            if (tokl == 0) { um1 = make_uint2(0, 0); if (!seq_start) um1 = *(const uint2*)(halo + FF + cg); }
            if (tokl < 2) { um2 = make_uint2(0, 0); if (!seq_start) um2 = *(const uint2*)(halo + (size_t)tokl * FF + cg); }
          }
        }
        float c0v = b4.x + w0.x * bflo(um2.x) + w1.x * bflo(um1.x) + w2.x * acc[ni][mi][4 * gq + 0];
        float c1v = b4.y + w0.y * bfhi(um2.x) + w1.y * bfhi(um1.x) + w2.y * acc[ni][mi][4 * gq + 1];
        float c2v = b4.z + w0.z * bflo(um2.y) + w1.z * bflo(um1.y) + w2.z * acc[ni][mi][4 * gq + 2];
        float c3v = b4.w + w0.w * bfhi(um2.y) + w1.w * bfhi(um1.y) + w2.w * acc[ni][mi][4 * gq + 3];
        uint2 ho;
        ho.x = pk2(gelu_t(c0v) * acc[ni + 2][mi][4 * gq + 0], gelu_t(c1v) * acc[ni + 2][mi][4 * gq + 1]);
        ho.y = pk2(gelu_t(c2v) * acc[ni + 2][mi][4 * gq + 2], gelu_t(c3v) * acc[ni + 2][mi][4 * gq + 3]);
        *(uint2*)(sh + tokl * 72 + cl) = ho;
      }
    }
  char* H = (char*)ws_P(p);
#pragma unroll
  for (int i = 0; i < 8; ++i) {
    const int row = (l_ >> 3) + 8 * i, ch = l_ & 7;
    uint4 v = *(const uint4*)(sh + row * 72 + ch * 8);
    *(uint4*)(H + (((unsigned)(m0 + wm_ * 64 + row)) * (unsigned)FF + (unsigned)(c0 + wn_ * 64 + ch * 8)) * 2u) = v;
  }
}

DI void ph_halo(const Ctx& p, int wi) {
  const int l_ = p.tid8 & 63, r = l_ & 31, h = l_ >> 5;
  const int hg = wi & 7, cg = wi >> 3;
  const int hrow = hg * 32 + r;
  int tok = 256 * (hrow >> 1) - 2 + (hrow & 1);
  tok = tok < 0 ? 0 : tok;
  const u16* wrow = ws_W(p) + W_UP + (size_t)(cg * 32 + r) * 1024 + h * 8;
  const u16* xrow = ws_xb(p) + (size_t)tok * 1024 + h * 8;
  f32x16 acc = zero16();
#pragma unroll 8
  for (int ks = 0; ks < 64; ++ks) {
    bf16x8 a = *(const bf16x8*)(wrow + ks * 16);
    bf16x8 bq = *(const bf16x8*)(xrow + ks * 16);
    acc = MFMA32(a, bq, acc);
  }
  u16* halo = (u16*)(p.ws + OFF_HALO);
#pragma unroll
  for (int gq = 0; gq < 4; ++gq) {
    uint2 o; o.x = pk2(acc[4 * gq + 0], acc[4 * gq + 1]); o.y = pk2(acc[4 * gq + 2], acc[4 * gq + 3]);
    *(uint2*)(halo + (size_t)hrow * FF + cg * 32 + 8 * gq + 4 * h) = o;
  }
}

DI void unpack8(uint4 v, float (&f)[8]) {
  f[0] = bflo(v.x); f[1] = bfhi(v.x); f[2] = bflo(v.y); f[3] = bfhi(v.y);
  f[4] = bflo(v.z); f[5] = bfhi(v.z); f[6] = bflo(v.w); f[7] = bfhi(v.w);
}

DI void ph_ffnh(const Ctx& p, int l, int item) {
  int task = item * 256 + p.tid;
  int rb = task / 352, cgp = task - rb * 352;
  int c0 = cgp * 8;
  size_t row0 = (size_t)rb * 16;
  int tseq = (int)(row0 & (SEQ - 1));
  const float* cw = p.kp.in[27] + (size_t)l * 3 * FF + c0;
  const float* cb = p.kp.in[28] + (size_t)l * FF + c0;
  float w0[8], w1[8], w2[8], bb[8];
  *(float4*)&w0[0] = *(const float4*)(cw); *(float4*)&w0[4] = *(const float4*)(cw + 4);
  *(float4*)&w1[0] = *(const float4*)(cw + FF); *(float4*)&w1[4] = *(const float4*)(cw + FF + 4);
  *(float4*)&w2[0] = *(const float4*)(cw + 2 * FF); *(float4*)&w2[4] = *(const float4*)(cw + 2 * FF + 4);
  *(float4*)&bb[0] = *(const float4*)(cb); *(float4*)&bb[4] = *(const float4*)(cb + 4);
  u16* UV = ws_P(p);
  float um2[8], um1[8];
  if (tseq > 0) {
    unpack8(*(const uint4*)(UV + (row0 - 2) * 5632 + c0), um2);
    unpack8(*(const uint4*)(UV + (row0 - 1) * 5632 + c0), um1);
  } else {
#pragma unroll
    for (int j = 0; j < 8; ++j) { um2[j] = 0.f; um1[j] = 0.f; }
  }
  for (int i4 = 0; i4 < 16; i4 += 4) {
    uint4 ur[4], vr[4];
#pragma unroll
    for (int i = 0; i < 4; ++i) {
      ur[i] = *(const uint4*)(UV + (row0 + i4 + i) * 5632 + c0);
      vr[i] = *(const uint4*)(UV + (row0 + i4 + i) * 5632 + FF + c0);
    }
#pragma unroll
    for (int i = 0; i < 4; ++i) {
      float u[8], v[8];
      unpack8(ur[i], u); unpack8(vr[i], v);
      float hh[8];
#pragma unroll
      for (int j = 0; j < 8; ++j) {
        float cv = bb[j] + w0[j] * um2[j] + w1[j] * um1[j] + w2[j] * u[j];
        hh[j] = gelu_t(cv) * v[j];
        um2[j] = um1[j]; um1[j] = u[j];
      }
      uint4 o; o.x = pk2(hh[0], hh[1]); o.y = pk2(hh[2], hh[3]); o.z = pk2(hh[4], hh[5]); o.w = pk2(hh[6], hh[7]);
      *(uint4*)(UV + (row0 + i4 + i) * 5632 + FF + c0) = o;
    }
  }
}

DI void hgrn_lfk(float fl, float lb, float& lf, float& kk) {
  fl = fminf(fmaxf(fl, -30.f), 30.f);
  float e = __expf(-fl);
  float sig = frcp(1.f + e);
  float f = lb + (1.f - lb) * sig;
  lf = __logf(f);
  kk = (1.f - lb) * e * sig;
}
DI float hgrn_lb(const Ctx& p, int l, int ch) {
  if (l == 0) return 0.f;
  float z0 = p.kp.in[5][ch], z1 = p.kp.in[5][512 + ch];
  return frcp(1.f + __expf(z0 - z1));
}


struct TilePf { uint4 v[4]; };
DI void tile_fetch(const Ctx& p, TilePf& t, const u16* __restrict__ src, size_t ld, int rows, int first_valid = 0) {
#pragma unroll
  for (int i = 0; i < 4; ++i) {
    const int idx = p.tid + 256 * i, rr = idx >> 4, cc = idx & 15;
    t.v[i] = make_uint4(0, 0, 0, 0);
    if (rr < rows && rr >= first_valid) t.v[i] = *(const uint4*)(src + (long)rr * (long)ld + cc * 8);
  }
}
DI void tile_put(const Ctx& p, const TilePf& t, u16* sdst, int rows) {
#pragma unroll
  for (int i = 0; i < 4; ++i) {
    const int idx = p.tid + 256 * i, rr = idx >> 4, cc = idx & 15;
    if (rr < rows) *(uint4*)(sdst + rr * 136 + cc * 8) = t.v[i];
  }
}
DI void load_tile128(const Ctx& p, u16* sdst, const u16* __restrict__ src, size_t ld, int rows, int first_valid = 0) {
  TilePf t;
  tile_fetch(p, t, src, ld, rows, first_valid);
  tile_put(p, t, sdst, rows);
}
DI void store_tile128(const Ctx& p, const u16* ssrc, u16* __restrict__ dst, size_t ld, int rows) {
  for (int idx = p.tid; idx < rows * 16; idx += 256) {
    int rr = idx >> 4, cc = idx & 15;
    *(uint4*)(dst + (size_t)rr * ld + cc * 8) = *(const uint4*)(ssrc + rr * 136 + cc * 8);
  }
}

DI void hgrnA_fetch(const Ctx& p, int it, TilePf& pf0, TilePf& pf1) {
  const int c = it & 127, hh = (it >> 7) & 3, b = it >> 9;
  const size_t row0 = (size_t)b * SEQ + c * 64;
  const u16* P = ws_P(p);
  tile_fetch(p, pf0, P + row0 * PW + C_HF + hh * 128, PW, 64);
  tile_fetch(p, pf1, P + row0 * PW + C_HI + hh * 128, PW, 64);
}
DI void hgrn_A(const Ctx& p, int l, int it, char* smem, TilePf& pf0, TilePf& pf1, bool primed, int it_next) {
  u16* sKT = (u16*)smem;
  u16* sIT = sKT + 128 * 72;
  u16* sF = sIT + 128 * 72;
  u16* sI = sF + 64 * 136;
  float* psum = (float*)(sI + 64 * 136);
  const int tid = p.tid, k = tid & 127, half = tid >> 7;
  const int c = it & 127, hh = (it >> 7) & 3, b = it >> 9;
  const size_t row0 = (size_t)b * SEQ + c * 64;
  const u16* P = ws_P(p);
  const float lb = hgrn_lb(p, l, hh * 128 + k);
  __syncthreads();
  if (!primed) hgrnA_fetch(p, it, pf0, pf1);
  tile_put(p, pf0, sF, 64);
  tile_put(p, pf1, sI, 64);
  __syncthreads();
  if (it_next >= 0) hgrnA_fetch(p, it_next, pf0, pf1);
  const u16* fp = sF + (half * 32) * 136 + k;
  const u16* ip = sI + (half * 32) * 136 + k;
  float s = 0.f;
  float lfa[32], kka[32];
#pragma unroll
  for (int t = 0; t < 32; ++t) { hgrn_lfk(bf2f(fp[t * 136]), lb, lfa[t], kka[t]); s += lfa[t]; }
  psum[half * 128 + k] = s;
  __syncthreads();
  const float base = half ? psum[k] : 0.f;
  const float total = psum[k] + psum[128 + k];
  float bb = base;
#pragma unroll
  for (int t8 = 0; t8 < 4; ++t8) {
    float kv[8]; u16 iv[8];
#pragma unroll
    for (int j = 0; j < 8; ++j) {
      int t = t8 * 8 + j;
      bb += lfa[t];
      kv[j] = kka[t] * __expf(total - bb);
      iv[j] = ip[t * 136];
    }
    uint4 ko; ko.x = pk2(kv[0], kv[1]); ko.y = pk2(kv[2], kv[3]); ko.z = pk2(kv[4], kv[5]); ko.w = pk2(kv[6], kv[7]);
    *(uint4*)(sKT + k * 72 + half * 32 + t8 * 8) = ko;
    uint4 io; io.x = iv[0] | ((u32)iv[1] << 16); io.y = iv[2] | ((u32)iv[3] << 16); io.z = iv[4] | ((u32)iv[5] << 16); io.w = iv[6] | ((u32)iv[7] << 16);
    *(uint4*)(sIT + k * 72 + half * 32 + t8 * 8) = io;
  }
  if (half == 0) ((float*)(p.ws + OFF_DEC))[(size_t)it * 128 + k] = __expf(total);
  __syncthreads();
  const int l_ = tid & 63, w = tid >> 6, kn = w & 1, vm = w >> 1, r = l_ & 31, h = l_ >> 5;
  f32x16 acc[2][2];
#pragma unroll
  for (int i = 0; i < 2; ++i)
#pragma unroll
    for (int j = 0; j < 2; ++j) acc[i][j] = zero16();
#pragma unroll
  for (int ks = 0; ks < 4; ++ks) {
    bf16x8 a[2], bq[2];
#pragma unroll
    for (int ni = 0; ni < 2; ++ni) a[ni] = *(const bf16x8*)(sKT + (kn * 64 + ni * 32 + r) * 72 + ks * 16 + h * 8);
#pragma unroll
    for (int mi = 0; mi < 2; ++mi) bq[mi] = *(const bf16x8*)(sIT + (vm * 64 + mi * 32 + r) * 72 + ks * 16 + h * 8);
#pragma unroll
    for (int ni = 0; ni < 2; ++ni)
#pragma unroll
      for (int mi = 0; mi < 2; ++mi) acc[ni][mi] = MFMA32(a[ni], bq[mi], acc[ni][mi]);
  }
  u16* HS = ws_HS(p) + (size_t)it * 16384;
  __syncthreads();
  {
    u16* sl = (u16*)smem + w * 4608;
#pragma unroll
    for (int ni = 0; ni < 2; ++ni)
#pragma unroll
      for (int mi = 0; mi < 2; ++mi)
#pragma unroll
        for (int gq = 0; gq < 4; ++gq) {
          uint2 o; o.x = pk2(acc[ni][mi][4 * gq], acc[ni][mi][4 * gq + 1]); o.y = pk2(acc[ni][mi][4 * gq + 2], acc[ni][mi][4 * gq + 3]);
          *(uint2*)(sl + (mi * 32 + r) * 72 + ni * 32 + 8 * gq + 4 * h) = o;
        }
#pragma unroll
    for (int i = 0; i < 8; ++i) {
      const int row = (l_ >> 3) + 8 * i, ch = l_ & 7;
      uint4 vv = *(const uint4*)(sl + row * 72 + ch * 8);
      *(uint4*)(HS + (vm * 64 + row) * 128 + kn * 64 + ch * 8) = vv;
    }
  }
}

DI void hgrn_B(const Ctx& p, int item) {
  int e2 = item * 256 + p.tid;
  int bh = e2 >> 13;
  int vk = (e2 & 8191) * 2;
  int k = vk & 127;
  u32* hs = (u32*)ws_HS(p);
  const float* dec = (const float*)(p.ws + OFF_DEC);
  float s0 = 0.f, s1 = 0.f;
  for (int c16 = 0; c16 < 128; c16 += 16) {
    u32 v[16]; float2 d[16];
#pragma unroll
    for (int i = 0; i < 16; ++i) {
      size_t idx = (((size_t)(bh * 128 + c16 + i)) * 16384 + vk) >> 1;
      v[i] = hs[idx];
      d[i] = *(const float2*)(dec + (size_t)(bh * 128 + c16 + i) * 128 + k);
    }
#pragma unroll
    for (int i = 0; i < 16; ++i) {
      size_t idx = (((size_t)(bh * 128 + c16 + i)) * 16384 + vk) >> 1;
      hs[idx] = pk2(s0, s1);
      s0 = d[i].x * s0 + bflo(v[i]);
      s1 = d[i].y * s1 + bfhi(v[i]);
    }
  }
}

DI void hgrnC_fetch(const Ctx& p, int it, TilePf& pf0, TilePf& pf1, TilePf& pf2) {
  const int c = it & 127, hh = (it >> 7) & 3, b = it >> 9;
  const size_t row0 = (size_t)b * SEQ + c * 64;
  const u16* P = ws_P(p);
  tile_fetch(p, pf0, P + row0 * PW + C_HF + hh * 128, PW, 64);
  tile_fetch(p, pf1, P + row0 * PW + C_HQ + hh * 128, PW, 64);
  tile_fetch(p, pf2, P + row0 * PW + C_HI + hh * 128, PW, 64);
}
DI void hgrn_C(const Ctx& p, int l, int it, char* smem, TilePf& pf0, TilePf& pf1, TilePf& pf2, bool primed, int it_next) {
  u16* sQ = (u16*)smem;
  u16* sK = sQ + 64 * 136;
  u16* sIT = sK + 64 * 136;
  u16* sI = sIT + 128 * 72;
  float* psum = (float*)(sI + 64 * 136);
  float* red = psum + 256;
  const int tid = p.tid, k = tid & 127, half = tid >> 7;
  const int c = it & 127, hh = (it >> 7) & 3, b = it >> 9;
  const size_t row0 = (size_t)b * SEQ + c * 64;
  u16* P = ws_P(p);
  const float lb = hgrn_lb(p, l, hh * 128 + k);
  __syncthreads();
  if (!primed) hgrnC_fetch(p, it, pf0, pf1, pf2);
  tile_put(p, pf0, sK, 64);
  tile_put(p, pf1, sQ, 64);
  tile_put(p, pf2, sI, 64);
  __syncthreads();
  if (it_next >= 0) hgrnC_fetch(p, it_next, pf0, pf1, pf2);
  u16* fp = sK + (half * 32) * 136 + k;
  u16* qp = sQ + (half * 32) * 136 + k;
  const u16* ip = sI + (half * 32) * 136 + k;
  float s = 0.f;
  float lfa[32], kka[32];
#pragma unroll
  for (int t = 0; t < 32; ++t) { hgrn_lfk(bf2f(fp[t * 136]), lb, lfa[t], kka[t]); s += lfa[t]; }
  psum[half * 128 + k] = s;
  __syncthreads();
  float bb = half ? psum[k] : 0.f;
#pragma unroll
  for (int t8 = 0; t8 < 4; ++t8) {
    u16 iv[8];
#pragma unroll
    for (int j = 0; j < 8; ++j) {
      int t = t8 * 8 + j;
      bb += lfa[t];
      float q = bf2f(qp[t * 136]);
      float eb = __expf(bb);
      qp[t * 136] = f2bf(q * eb);
      fp[t * 136] = f2bf(kka[t] * __expf(-bb));
      iv[j] = ip[t * 136];
    }
    uint4 io; io.x = iv[0] | ((u32)iv[1] << 16); io.y = iv[2] | ((u32)iv[3] << 16); io.z = iv[4] | ((u32)iv[5] << 16); io.w = iv[6] | ((u32)iv[7] << 16);
    *(uint4*)(sIT + k * 72 + half * 32 + t8 * 8) = io;
  }
  __syncthreads();
  load_tile128(p, sI, P + row0 * PW + C_HG + hh * 128, PW, 64);
  const int l_ = tid & 63, w = tid >> 6, tt = w & 1, vh = w >> 1, r = l_ & 31, h = l_ >> 5;
  f32x16 att0 = zero16(), att1 = zero16();
#pragma unroll
  for (int ks = 0; ks < 8; ++ks) {
    bf16x8 bq = *(const bf16x8*)(sQ + (tt * 32 + r) * 136 + ks * 16 + h * 8);
    bf16x8 a0 = *(const bf16x8*)(sK + (r) * 136 + ks * 16 + h * 8);
    att0 = MFMA32(a0, bq, att0);
    if (tt) {
      bf16x8 a1 = *(const bf16x8*)(sK + (32 + r) * 136 + ks * 16 + h * 8);
      att1 = MFMA32(a1, bq, att1);
    }
  }
#pragma unroll
  for (int reg = 0; reg < 16; ++reg) {
    bool keep = crow(reg, h) <= r;
    if (tt) att1[reg] = keep ? att1[reg] : 0.f; else att0[reg] = keep ? att0[reg] : 0.f;
  }
  f32x16 o[2]; o[0] = zero16(); o[1] = zero16();
  {
    bf16x8 pf0 = pack8<0>(att0), pf1 = pack8<1>(att0);
#pragma unroll
    for (int vt = 0; vt < 2; ++vt) {
      const u16* base = sIT + (vh * 64 + vt * 32 + r) * 72 + 4 * h;
      o[vt] = MFMA32(cat4(*(const bf16x4*)(base), *(const bf16x4*)(base + 8)), pf0, o[vt]);
      o[vt] = MFMA32(cat4(*(const bf16x4*)(base + 16), *(const bf16x4*)(base + 24)), pf1, o[vt]);
    }
  }
  if (tt) {
    bf16x8 pf0 = pack8<0>(att1), pf1 = pack8<1>(att1);
#pragma unroll
    for (int vt = 0; vt < 2; ++vt) {
      const u16* base = sIT + (vh * 64 + vt * 32 + r) * 72 + 32 + 4 * h;
      o[vt] = MFMA32(cat4(*(const bf16x4*)(base), *(const bf16x4*)(base + 8)), pf0, o[vt]);
      o[vt] = MFMA32(cat4(*(const bf16x4*)(base + 16), *(const bf16x4*)(base + 24)), pf1, o[vt]);
    }
  }
  const u16* HS = ws_HS(p) + (size_t)it * 16384;
#pragma unroll
  for (int ks = 0; ks < 8; ++ks) {
    bf16x8 bq = *(const bf16x8*)(sQ + (tt * 32 + r) * 136 + ks * 16 + h * 8);
#pragma unroll
    for (int vt = 0; vt < 2; ++vt) {
      bf16x8 a = *(const bf16x8*)(HS + (vh * 64 + vt * 32 + r) * 128 + ks * 16 + h * 8);
      o[vt] = MFMA32(a, bq, o[vt]);
    }
  }
  float ss = 0.f;
#pragma unroll
  for (int vt = 0; vt < 2; ++vt)
#pragma unroll
    for (int reg = 0; reg < 16; ++reg) ss += o[vt][reg] * o[vt][reg];
  ss += __shfl_xor(ss, 32);
  if (h == 0) red[vh * 64 + tt * 32 + r] = ss;
  __syncthreads();
  const float tot = red[tt * 32 + r] + red[64 + tt * 32 + r];
  const float rinv = rsqrtf(tot * (1.f / 128.f) + 1e-6f);
  const float* ng = p.kp.in[6] + (size_t)l * 512 + hh * 128;
#pragma unroll
  for (int vt = 0; vt < 2; ++vt)
#pragma unroll
    for (int gq = 0; gq < 4; ++gq) {
      int v = vh * 64 + vt * 32 + 8 * gq + 4 * h;
      uint2 gv = *(const uint2*)(sI + (tt * 32 + r) * 136 + v);
      float4 n4 = *(const float4*)(ng + v);
      float g0 = bflo(gv.x), g1 = bfhi(gv.x), g2 = bflo(gv.y), g3 = bfhi(gv.y);
      float y0 = o[vt][4 * gq + 0] * rinv * n4.x * (g0 * sigmoidf_(g0));
      float y1 = o[vt][4 * gq + 1] * rinv * n4.y * (g1 * sigmoidf_(g1));
      float y2 = o[vt][4 * gq + 2] * rinv * n4.z * (g2 * sigmoidf_(g2));
      float y3 = o[vt][4 * gq + 3] * rinv * n4.w * (g3 * sigmoidf_(g3));
      uint2 ov; ov.x = pk2(y0, y1); ov.y = pk2(y2, y3);
      *(uint2*)(sQ + (tt * 32 + r) * 136 + v) = ov;
    }
  __syncthreads();
  store_tile128(p, sQ, P + row0 * PW + C_HQ + hh * 128, PW, 64);
}

template <bool FINAL>
DI void lru_fetch(const Ctx& p, int it, TilePf& pf0, TilePf& pf1) {
  const int g = it & 3, tile = (it >> 2) & 255, b = it >> 10;
  const int t0 = tile * 32;
  const u16* P = ws_P(p);
  tile_fetch(p, pf0, P + ((long)b * SEQ + t0 - 3) * (long)PW + C_LX + g * 128, PW, 35, (t0 == 0) ? 3 : 0);
  if (FINAL) tile_fetch(p, pf1, P + ((size_t)b * SEQ + t0) * PW + C_LY + g * 128, PW, 32);
}
template <bool FINAL>
DI void lru_item(const Ctx& p, int l, int it, char* smem, TilePf& pf0, TilePf& pf1, bool primed, int it_next) {
  u16* sXc = (u16*)smem;
  float* sA = (float*)(sXc + 32 * 136);
  float* sU = sA + 32 * 128;
  float* sC = sU + 32 * 128;
  u16* sXr = (u16*)(sC + 512);
  u16* sY = sXr + 35 * 136;
  const int tid = p.tid, c = tid & 127, half = tid >> 7;
  const int g = it & 3, tile = (it >> 2) & 255, b = it >> 10;
  const int t0 = tile * 32, ch = g * 128 + c;
  u16* P = ws_P(p);
  const float* cw = p.kp.in[13] + (size_t)l * 4 * 512;
  const float w0 = cw[ch], w1 = cw[512 + ch], w2 = cw[1024 + ch], w3 = cw[1536 + ch], cb = p.kp.in[14][l * 512 + ch];
  const int ts = t0 + half * 16;
  __syncthreads();
  if (!primed) lru_fetch<FINAL>(p, it, pf0, pf1);
  tile_put(p, pf0, sXr, 35);
  if (FINAL) tile_put(p, pf1, sY, 32);
  bf16x8 waf[8], wxf[8];
  {
    const int l0_ = tid & 63, w0_ = tid >> 6;
    const u16* wa_ = ws_W(p) + W_LA + g * 16384 + (w0_ * 32 + (l0_ & 31)) * 128 + (l0_ >> 5) * 8;
    const u16* wx_ = ws_W(p) + W_LX + g * 16384 + (w0_ * 32 + (l0_ & 31)) * 128 + (l0_ >> 5) * 8;
#pragma unroll
    for (int ks = 0; ks < 8; ++ks) { waf[ks] = *(const bf16x8*)(wa_ + ks * 16); wxf[ks] = *(const bf16x8*)(wx_ + ks * 16); }
  }
  __syncthreads();
  if (it_next >= 0) lru_fetch<FINAL>(p, it_next, pf0, pf1);
  {
    const u16* xr = sXr + (half * 16) * 136 + c;
    float x0 = bf2f(xr[0]), x1 = bf2f(xr[136]), x2 = bf2f(xr[2 * 136]);
#pragma unroll 4
    for (int i = 0; i < 16; ++i) {
      float x3 = bf2f(xr[(i + 3) * 136]);
      float xc = cb + w0 * x0 + w1 * x1 + w2 * x2 + w3 * x3;
      sXc[(half * 16 + i) * 136 + c] = f2bf(xc);
      x0 = x1; x1 = x2; x2 = x3;
    }
  }
  __syncthreads();
  const int l_ = tid & 63, w = tid >> 6, r = l_ & 31, h = l_ >> 5;
  f32x16 ar = zero16(), ai = zero16();
#pragma unroll
  for (int ks = 0; ks < 8; ++ks) {
    bf16x8 bx = *(const bf16x8*)(sXc + r * 136 + ks * 16 + h * 8);
    ar = MFMA32(waf[ks], bx, ar);
    ai = MFMA32(wxf[ks], bx, ai);
  }
  const float* bap = p.kp.in[16] + (size_t)l * 512 + g * 128;
  const float* bxp = p.kp.in[18] + (size_t)l * 512 + g * 128;
  const float* lmp = p.kp.in[19] + (size_t)l * 512 + g * 128;
#pragma unroll
  for (int gq = 0; gq < 4; ++gq) {
    int jb = w * 32 + 8 * gq + 4 * h;
    float4 ba4 = *(const float4*)(bap + jb), bx4 = *(const float4*)(bxp + jb), lm4 = *(const float4*)(lmp + jb);
    float bav[4] = {ba4.x, ba4.y, ba4.z, ba4.w}, bxv[4] = {bx4.x, bx4.y, bx4.z, bx4.w}, lmv[4] = {lm4.x, lm4.y, lm4.z, lm4.w};
    float av[4], uv[4];
#pragma unroll
    for (int jj = 0; jj < 4; ++jj) {
      float rr = sigmoidf_(ar[4 * gq + jj] + bav[jj]);
      float ii = sigmoidf_(ai[4 * gq + jj] + bxv[jj]);
      float ex = __expf(-lmv[jj]);
      float sp = (ex < 0.03f) ? ex * (1.f - ex * (0.5f - ex * (0.33333334f - 0.25f * ex))) : __logf(1.f + ex);
      float la = -8.f * rr * sp;
      float aa = __expf(la);
      av[jj] = aa;
      float x2 = 2.f * la;
      float om = (x2 > -0.03f) ? -x2 * (1.f + x2 * (0.5f + x2 * (0.16666667f + 0.041666668f * x2))) : 1.f - aa * aa;
      float xcv = bf2f(sXc[r * 136 + jb + jj]);
      uv[jj] = __builtin_amdgcn_sqrtf(fmaxf(om, 0.f)) * ii * xcv;
    }
    *(float4*)(sA + r * 128 + jb) = make_float4(av[0], av[1], av[2], av[3]);
    *(float4*)(sU + r * 128 + jb) = make_float4(uv[0], uv[1], uv[2], uv[3]);
  }
  __syncthreads();
  float A = 1.f, H = 0.f;
#pragma unroll 4
  for (int i = 0; i < 16; ++i) {
    float a = sA[(half * 16 + i) * 128 + c], u = sU[(half * 16 + i) * 128 + c];
    H = a * H + u; A *= a;
  }
  sC[(half * 128 + c) * 2] = A; sC[(half * 128 + c) * 2 + 1] = H;
  __syncthreads();
  const float A0 = sC[c * 2], H0 = sC[c * 2 + 1], A1 = sC[(128 + c) * 2], H1 = sC[(128 + c) * 2 + 1];
  const size_t ci = ((size_t)(b * 256 + tile)) * 512 + ch;
  float* carA = (float*)(p.ws + OFF_CARA);
  float* carH = (float*)(p.ws + OFF_CARH);
  if (!FINAL) {
    if (half == 0) { carA[ci] = A0 * A1; carH[ci] = A1 * H0 + H1; }
  } else {
    float hin = ((const float*)(p.ws + OFF_CARI))[ci];
    float hs = half ? (A0 * hin + H0) : hin;
#pragma unroll 4
    for (int i = 0; i < 16; ++i) {
      float a = sA[(half * 16 + i) * 128 + c], u = sU[(half * 16 + i) * 128 + c];
      hs = a * hs + u;
      float y = bf2f(sY[(half * 16 + i) * 136 + c]);
      sY[(half * 16 + i) * 136 + c] = f2bf(hs * gelu_t(y));
    }
    __syncthreads();
    store_tile128(p, sY, P + ((size_t)b * SEQ + t0) * PW + C_LY + g * 128, PW, 32);
  }
}

DI void lru_B(const Ctx& p, int item) {
  int chain = item * 256 + p.tid;
  int b = chain >> 9, ch = chain & 511;
  const float* __restrict__ carA = (const float*)(p.ws + OFF_CARA);
  const float* __restrict__ carH = (const float*)(p.ws + OFF_CARH);
  float* __restrict__ hin = (float*)(p.ws + OFF_CARI);
  float s = 0.f;
  for (int t32 = 0; t32 < 256; t32 += 32) {
    float A[32], H[32];
#pragma unroll
    for (int i = 0; i < 32; ++i) {
      size_t ci = ((size_t)(b * 256 + t32 + i)) * 512 + ch;
      A[i] = carA[ci]; H[i] = carH[ci];
    }
#pragma unroll
    for (int i = 0; i < 32; ++i) {
      size_t ci = ((size_t)(b * 256 + t32 + i)) * 512 + ch;
      hin[ci] = s;
      s = A[i] * s + H[i];
    }
  }
}

DI void nsa_compress(const Ctx& p, int l, int it, char* smem) {
  u16* sT = (u16*)smem;
  float* sPart = (float*)smem;
  float* sH = (float*)(smem + 32768);
  const int tid = p.tid, l_ = tid & 63, w = tid >> 6, r = l_ & 31, h = l_ >> 5;
  const int kv = it & 1, grp = (it >> 1) & 15, g = (it >> 5) & 1, b = it >> 6;
  const float* w2 = p.kp.in[kv ? 12 : 9] + (size_t)l * 64 * 64;
  const u16* w1f = (const u16*)(p.ws + OFF_W1F) + (size_t)kv * 131072;
  const float* pev = (const float*)(p.ws + OFF_PEV) + kv * 64;
  const int n0 = grp * 32, col = (kv ? C_VC : C_KC) + g * 64;
  const u16* P = ws_P(p);
  __syncthreads();
#pragma unroll
  for (int bt = 0; bt < 3; ++bt) {
    uint4 v[6];
#pragma unroll
    for (int i = 0; i < 6; ++i) {
      const int idx = tid + 256 * (bt * 6 + i);
      const int rr = idx >> 3, c = idx & 7;
      const int t = 16 * n0 + rr;
      v[i] = make_uint4(0, 0, 0, 0);
      if (idx < 528 * 8 && t < SEQ) v[i] = *(const uint4*)(P + ((size_t)b * SEQ + t) * PW + col + c * 8);
    }
#pragma unroll
    for (int i = 0; i < 6; ++i) {
      const int idx = tid + 256 * (bt * 6 + i);
      const int rr = idx >> 3, c = idx & 7;
      if (idx < 528 * 8) *(uint4*)(sT + rr * 64 + ((c ^ ((rr >> 4) & 7)) * 8)) = v[i];
    }
  }
  __syncthreads();
  f32x16 acc[2]; acc[0] = zero16(); acc[1] = zero16();
#pragma unroll 8
  for (int si = 0; si < 32; ++si) {
    const int s_ = w * 32 + si;
    const int p_ = s_ >> 2;
    const int row = 16 * r + p_;
    const int c = (s_ & 3) * 2 + h;
    bf16x8 bx = *(const bf16x8*)(sT + row * 64 + ((c ^ ((row >> 4) & 7)) * 8));
    bf16x8 a0 = *(const bf16x8*)(w1f + ((size_t)(0 * 128 + s_) * 64 + l_) * 8);
    bf16x8 a1 = *(const bf16x8*)(w1f + ((size_t)(1 * 128 + s_) * 64 + l_) * 8);
    acc[0] = MFMA32(a0, bx, acc[0]);
    acc[1] = MFMA32(a1, bx, acc[1]);
  }
  __syncthreads();
#pragma unroll
  for (int jt = 0; jt < 2; ++jt)
#pragma unroll
    for (int gq = 0; gq < 4; ++gq)
      *(float4*)(sPart + (w * 32 + r) * 64 + jt * 32 + 8 * gq + 4 * h) =
          make_float4(acc[jt][4 * gq + 0], acc[jt][4 * gq + 1], acc[jt][4 * gq + 2], acc[jt][4 * gq + 3]);
  __syncthreads();
  {
    const int nb = tid >> 3, jq = (tid & 7) * 8;
    float hv[8];
#pragma unroll
    for (int e = 0; e < 8; ++e)
      hv[e] = gelu_t(sPart[(0 * 32 + nb) * 64 + jq + e] + sPart[(1 * 32 + nb) * 64 + jq + e] + sPart[(2 * 32 + nb) * 64 + jq + e] +
                     sPart[(3 * 32 + nb) * 64 + jq + e] + pev[jq + e]);
    __syncthreads();
#pragma unroll
    for (int e = 0; e < 8; ++e) sH[nb * 64 + jq + e] = hv[e];
  }
  __syncthreads();
  {
    const int nb = tid >> 3, dq = (tid & 7) * 8;
    float o[8];
#pragma unroll
    for (int e = 0; e < 8; ++e) o[e] = 0.f;
#pragma unroll 4
    for (int jj = 0; jj < 64; ++jj) {
      const float hvj = sH[nb * 64 + jj];
      const float4 wa = *(const float4*)(w2 + jj * 64 + dq), wb = *(const float4*)(w2 + jj * 64 + dq + 4);
      o[0] += hvj * wa.x; o[1] += hvj * wa.y; o[2] += hvj * wa.z; o[3] += hvj * wa.w;
      o[4] += hvj * wb.x; o[5] += hvj * wb.y; o[6] += hvj * wb.z; o[7] += hvj * wb.w;
    }
    const int n = n0 + nb;
    if (n >= 511) {
#pragma unroll
      for (int e = 0; e < 8; ++e) o[e] = 0.f;
    }
    if (kv == 0) {
      uint4 ov; ov.x = pk2(o[0], o[1]); ov.y = pk2(o[2], o[3]); ov.z = pk2(o[4], o[5]); ov.w = pk2(o[6], o[7]);
      *(uint4*)((u16*)(p.ws + OFF_KCG) + ((size_t)(b * 2 + g) * 512 + n) * 64 + dq) = ov;
    } else {
      u16* vcT = (u16*)(p.ws + OFF_VCT) + (size_t)(b * 2 + g) * 64 * 512;
#pragma unroll
      for (int e = 0; e < 8; ++e) vcT[(size_t)(dq + e) * 512 + n] = f2bf(o[e]);
    }
  }
}

DI void nsa_vtrans(const Ctx& p, int it, char* smem) {
  u16* sT = (u16*)smem;
  const int tid = p.tid;
  const int which = it & 1, tb = it >> 1;
  const int b = tb >> 7, tblk = tb & 127;
  const int col = which ? C_VW : C_VS;
  u16* dst = (u16*)(p.ws + (which ? OFF_VWT : OFF_VST));
  const u16* P = ws_P(p);
  const size_t row0 = (size_t)b * SEQ + tblk * 64;
  __syncthreads();
#pragma unroll
  for (int i = 0; i < 4; ++i) {
    int idx = tid + 256 * i; int rr = idx >> 4, cc = idx & 15;
    uint4 v = *(const uint4*)(P + (row0 + rr) * PW + col + cc * 8);
    u32* d = (u32*)(sT + rr * 130 + cc * 8);
    d[0] = v.x; d[1] = v.y; d[2] = v.z; d[3] = v.w;
  }
  __syncthreads();
  const int gd = tid >> 1, half = tid & 1;
#pragma unroll
  for (int q = 0; q < 4; ++q) {
    u16 e[8];
#pragma unroll
    for (int j = 0; j < 8; ++j) e[j] = sT[(half * 32 + q * 8 + j) * 130 + gd];
    uint4 o; o.x = e[0] | ((u32)e[1] << 16); o.y = e[2] | ((u32)e[3] << 16); o.z = e[4] | ((u32)e[5] << 16); o.w = e[6] | ((u32)e[7] << 16);
    *(uint4*)(dst + ((size_t)(b * 128 + gd)) * SEQ + tblk * 64 + half * 32 + q * 8) = o;
  }
}

struct FlashState { f32x16 o[2]; float m, l; };
DI void flash_init(FlashState& s) { s.o[0] = zero16(); s.o[1] = zero16(); s.m = -INFINITY; s.l = 0.f; }

DI void nsa_load_tile(const Ctx& p, u16* sdst, const u16* __restrict__ src, size_t ld, int rows) {
  const int tid = p.tid8;
  for (int rr = tid >> 3; rr < rows; rr += 64) {
    uint4 v = *(const uint4*)(src + (size_t)rr * ld + (tid & 7) * 8);
    *(uint4*)(sdst + rr * 72 + (tid & 7) * 8) = v;
  }
}

template <bool MASKED, int PS>
DI void flash_sub2(FlashState& st, const u16* sQrow, const u16* sK, const u16* sVT, int sub, float slope2,
                   bool tokflag, int dist0, int maxdist, int r, int h) {
  const int d0h = dist0 - PS * 4 * h;
  const float base = -slope2 * (float)d0h;
  const float sps = slope2 * (float)PS;
  f32x16 s = zero16();
#pragma unroll
  for (int ks = 0; ks < 4; ++ks) {
    bf16x8 a = *(const bf16x8*)(sK + (sub * 32 + r) * 72 + ks * 16 + h * 8);
    bf16x8 qv = *(const bf16x8*)(sQrow + ks * 16);
    s = MFMA32(a, qv, s);
  }
  float mx = -INFINITY;
#pragma unroll
  for (int reg = 0; reg < 16; ++reg) {
    const int creg = (reg & 3) + 8 * (reg >> 2);
    float x = fmaf(s[reg], 1.4426950408889634f, fmaf(sps, (float)creg, base));
    if (MASKED) {
      int dist = d0h - PS * creg;
      x = (dist >= 0 && dist < maxdist) ? x : -INFINITY;
    }
    s[reg] = x;
    mx = fmaxf(mx, x);
  }
  mx = fmaxf(mx, __shfl_xor(mx, 32));
  mx = tokflag ? mx : -INFINITY;
  const float m_new = fmaxf(st.m, mx);
  const float m_use = (m_new == -INFINITY) ? 0.f : m_new;
  const float alpha = __builtin_amdgcn_exp2f(st.m - m_use);
  const float ml = tokflag ? m_use : INFINITY;
  float rs = 0.f;
#pragma unroll
  for (int reg = 0; reg < 16; ++reg) { float pv = __builtin_amdgcn_exp2f(s[reg] - ml); s[reg] = pv; rs += pv; }
  rs += __shfl_xor(rs, 32);
  st.l = st.l * alpha + rs;
  st.m = m_new;
  if (__any(alpha != 1.f)) {
#pragma unroll
    for (int dt = 0; dt < 2; ++dt)
#pragma unroll
      for (int reg = 0; reg < 16; ++reg) st.o[dt][reg] *= alpha;
  }
  bf16x8 pf0 = pack8<0>(s), pf1 = pack8<1>(s);
#pragma unroll
  for (int dt = 0; dt < 2; ++dt) {
    const u16* base_v = sVT + (dt * 32 + r) * 72 + sub * 32 + 4 * h;
    st.o[dt] = MFMA32(cat4(*(const bf16x4*)(base_v), *(const bf16x4*)(base_v + 8)), pf0, st.o[dt]);
    st.o[dt] = MFMA32(cat4(*(const bf16x4*)(base_v + 16), *(const bf16x4*)(base_v + 24)), pf1, st.o[dt]);
  }
}

template <int PS>
DI void flash_full(FlashState& st, const u16* sQrow, const u16* sK, const u16* sVT, float slope2,
                   bool tokflag, int dist0, int r, int h) {
  const int d0h = dist0 - PS * 4 * h;
  const float base = -slope2 * (float)d0h;
  const float sps = slope2 * (float)PS;
  f32x16 s0 = zero16(), s1 = zero16();
#pragma unroll
  for (int ks = 0; ks < 4; ++ks) {
    bf16x8 qv = *(const bf16x8*)(sQrow + ks * 16);
    bf16x8 a0 = *(const bf16x8*)(sK + r * 72 + ks * 16 + h * 8);
    bf16x8 a1 = *(const bf16x8*)(sK + (32 + r) * 72 + ks * 16 + h * 8);
    s0 = MFMA32(a0, qv, s0);
    s1 = MFMA32(a1, qv, s1);
  }
  float mx = -INFINITY;
#pragma unroll
  for (int reg = 0; reg < 16; ++reg) {
    const int creg = (reg & 3) + 8 * (reg >> 2);
    float x0 = fmaf(s0[reg], 1.4426950408889634f, fmaf(sps, (float)creg, base));
    float x1 = fmaf(s1[reg], 1.4426950408889634f, fmaf(sps, (float)(creg + 32), base));
    s0[reg] = x0; s1[reg] = x1;
    mx = fmaxf(mx, fmaxf(x0, x1));
  }
  mx = fmaxf(mx, __shfl_xor(mx, 32));
  mx = tokflag ? mx : -INFINITY;
  const float m_new = fmaxf(st.m, mx);
  const float m_use = (m_new == -INFINITY) ? 0.f : m_new;
  const float alpha = __builtin_amdgcn_exp2f(st.m - m_use);
  const float ml = tokflag ? m_use : INFINITY;
  float rs = 0.f;
#pragma unroll
  for (int reg = 0; reg < 16; ++reg) {
    float p0 = __builtin_amdgcn_exp2f(s0[reg] - ml), p1 = __builtin_amdgcn_exp2f(s1[reg] - ml);
    s0[reg] = p0; s1[reg] = p1; rs += p0 + p1;
  }
  rs += __shfl_xor(rs, 32);
  st.l = st.l * alpha + rs;
  st.m = m_new;
  if (__any(alpha != 1.f)) {
#pragma unroll
    for (int dt = 0; dt < 2; ++dt)
#pragma unroll
      for (int reg = 0; reg < 16; ++reg) st.o[dt][reg] *= alpha;
  }
  bf16x8 pf0 = pack8<0>(s0), pf1 = pack8<1>(s0), pf2 = pack8<0>(s1), pf3 = pack8<1>(s1);
#pragma unroll
  for (int dt = 0; dt < 2; ++dt) {
    const u16* bv = sVT + (dt * 32 + r) * 72 + 4 * h;
    st.o[dt] = MFMA32(cat4(*(const bf16x4*)(bv), *(const bf16x4*)(bv + 8)), pf0, st.o[dt]);
    st.o[dt] = MFMA32(cat4(*(const bf16x4*)(bv + 16), *(const bf16x4*)(bv + 24)), pf1, st.o[dt]);
    st.o[dt] = MFMA32(cat4(*(const bf16x4*)(bv + 32), *(const bf16x4*)(bv + 40)), pf2, st.o[dt]);
    st.o[dt] = MFMA32(cat4(*(const bf16x4*)(bv + 48), *(const bf16x4*)(bv + 56)), pf3, st.o[dt]);
  }
}

template <int PS>
DI void flash_tile(FlashState& st, const u16* sQrow, const u16* sK, const u16* sVT, float slope2,
                   int t, int tmin, int pos0, int maxdist, bool tokflag, int r, int h) {
  if (pos0 + PS * 63 <= tmin && tmin + 31 - pos0 < maxdist) {
    flash_full<PS>(st, sQrow, sK, sVT, slope2, tokflag, t - pos0, r, h);
    return;
  }
#pragma unroll
  for (int sub = 1; sub >= 0; --sub) {
    const int pfirst = pos0 + PS * 32 * sub, plast = pfirst + PS * 31;
    if (pfirst > tmin + 31 || tmin - plast >= maxdist) continue;
    const bool need_mask = (plast > tmin) || (tmin + 31 - pfirst >= maxdist);
    if (need_mask) flash_sub2<true, PS>(st, sQrow, sK, sVT, sub, slope2, tokflag, t - pfirst, maxdist, r, h);
    else flash_sub2<false, PS>(st, sQrow, sK, sVT, sub, slope2, tokflag, t - pfirst, maxdist, r, h);
  }
}

DI int prev_bit128(u64 m0, u64 m1, int start) {
  if (start >= 64) { u64 x = m1 << (127 - start); if (x) return start - __builtin_clzll(x); start = 63; }
  if (start >= 0) { u64 x = m0 << (63 - start); if (x) return start - __builtin_clzll(x); }
  return -1;
}

DI int next_bit128(u64 m0, u64 m1, int start) {
  if (start < 64) { u64 x = m0 >> start; if (x) return start + __builtin_ctzll(x); start = 64; }
  if (start < 128) { u64 x = m1 >> (start - 64); if (x) return start + __builtin_ctzll(x); }
  return 128;
}

DI void nsa_attn(const Ctx& p, int it_, char* smem) {
  const int it = __builtin_amdgcn_readfirstlane(it_);
  u16* sK = (u16*)smem;
  u16* sVT = sK + 64 * 72;
  u16* sQ = sVT + 64 * 72;
  float* sML = (float*)(sQ + 256 * 72);
  float* sImpA = sML + 512;
  float* sImpB = sImpA + 64 * 129;
  u64* sSel = (u64*)(sImpB + 64 * 129);
  u16* sK2 = (u16*)(sSel + 128);
  u16* sVT2 = sK2 + 64 * 72;
  const int tid = p.tid8, l_ = tid & 63, w = tid >> 6, r = l_ & 31, h = l_ >> 5;
  const int hw = w & 3, th = w >> 2, qrow = (th * 4 + hw) * 32 + r, tokl = th * 32 + r;
  const int bg = it & 7, tile = 127 - (it >> 3);
  const int b = bg >> 1, g = bg & 1;
  const int t0 = tile * 64, cur = tile;
  const int t = t0 + tokl;
  const int head = g * 4 + hw;
  const float slope2 = exp2f(-(float)(head + 1)) * 1.4426950408889634f;
  const int tmin = t0 + th * 32;
  u16* P = ws_P(p);
  const u16* kcG = (const u16*)(p.ws + OFF_KCG) + (size_t)(b * 2 + g) * 512 * 64;
  const u16* vcT = (const u16*)(p.ws + OFF_VCT) + (size_t)(b * 2 + g) * 64 * 512;
  const u16* vsT = (const u16*)(p.ws + OFF_VST) + (size_t)(b * 128 + g * 64) * SEQ;
  const u16* vwT = (const u16*)(p.ws + OFF_VWT) + (size_t)(b * 128 + g * 64) * SEQ;
  const size_t rowt = (size_t)b * SEQ + t;
  __syncthreads();
  const u16* sQrow = sQ + qrow * 72 + h * 8;
#pragma unroll
  for (int ks = 0; ks < 4; ++ks) {
    uint4 v = *(const uint4*)(P + rowt * PW + C_NQ + head * 64 + ks * 16 + h * 8);
    float f[8]; unpack8(v, f);
    uint4 o; o.x = pk2(f[0] * 0.125f, f[1] * 0.125f); o.y = pk2(f[2] * 0.125f, f[3] * 0.125f);
    o.z = pk2(f[4] * 0.125f, f[5] * 0.125f); o.w = pk2(f[6] * 0.125f, f[7] * 0.125f);
    *(uint4*)(sQ + qrow * 72 + ks * 16 + h * 8) = o;
  }
  const u16* gp = P + rowt * PW + C_NG + head * 3;
  const float g_cmp = sigmoidf_(bf2f(gp[0])), g_sel = sigmoidf_(bf2f(gp[1])), g_win = sigmoidf_(bf2f(gp[2]));
  for (int i = tid; i < 2 * 64 * 129; i += 512) sImpA[i] = 0.f;
  FlashState fs;
  const int nmax = (t0 + 32) >> 4;
  flash_init(fs);
  const int lrow = tid >> 3, lch = (tid & 7) * 8;
  uint4 kr, vr;
#define KV_STORE { *(uint4*)(sK + lrow * 72 + lch) = kr; *(uint4*)(sVT + lrow * 72 + lch) = vr; }
  {
    const int ntl = nmax >> 6;
    kr = *(const uint4*)(kcG + (size_t)(ntl * 64 + lrow) * 64 + lch);
    vr = *(const uint4*)(vcT + (size_t)lrow * 512 + ntl * 64 + lch);
    for (int nt = ntl; nt >= 0; --nt) {
      __syncthreads();
      KV_STORE
      __syncthreads();
      if (nt > 0) {
        kr = *(const uint4*)(kcG + (size_t)((nt - 1) * 64 + lrow) * 64 + lch);
        vr = *(const uint4*)(vcT + (size_t)lrow * 512 + (nt - 1) * 64 + lch);
      }
      flash_tile<16>(fs, sQrow, sK, sVT, slope2, t, tmin, 16 * (nt * 64) + 31, 0x40000000, true, r, h);
    }
  }
  u32 ocmp[16];
  {
    float inv = g_cmp * frcp(fmaxf(fs.l, 1e-30f));
#pragma unroll
    for (int dt = 0; dt < 2; ++dt)
#pragma unroll
      for (int gq = 0; gq < 4; ++gq) {
        ocmp[dt * 8 + 2 * gq + 0] = pk2(fs.o[dt][4 * gq + 0] * inv, fs.o[dt][4 * gq + 1] * inv);
        ocmp[dt * 8 + 2 * gq + 1] = pk2(fs.o[dt][4 * gq + 2] * inv, fs.o[dt][4 * gq + 3] * inv);
      }
    if (h == 0) { sML[qrow * 2] = fs.m; sML[qrow * 2 + 1] = fs.l; }
  }
  uint4 ir0 = *(const uint4*)(kcG + (size_t)lrow * 64 + lch), ir1 = *(const uint4*)(kcG + (size_t)(64 + lrow) * 64 + lch);
  for (int rd = 0; rd <= (nmax >> 7); ++rd) {
    __syncthreads();
    *(uint4*)(sK + lrow * 72 + lch) = ir0;
    *(uint4*)(sK + (64 + lrow) * 72 + lch) = ir1;
    __syncthreads();
    if (rd < (nmax >> 7)) {
      ir0 = *(const uint4*)(kcG + (size_t)((rd + 1) * 128 + lrow) * 64 + lch);
      ir1 = *(const uint4*)(kcG + (size_t)((rd + 1) * 128 + 64 + lrow) * 64 + lch);
    }
    const int nbase = rd * 128 + hw * 32;
    f32x16 ps = zero16();
#pragma unroll
    for (int hq = 0; hq < 4; ++hq) {
      f32x16 s = zero16();
#pragma unroll
      for (int ks = 0; ks < 4; ++ks) {
        bf16x8 a = *(const bf16x8*)(sK + (hw * 32 + r) * 72 + ks * 16 + h * 8);
        bf16x8 bq = *(const bf16x8*)(sQ + ((th * 4 + hq) * 32 + r) * 72 + ks * 16 + h * 8);
        s = MFMA32(a, bq, s);
      }
      const float mm = sML[((th * 4 + hq) * 32 + r) * 2], ll = sML[((th * 4 + hq) * 32 + r) * 2 + 1];
      const float m_use = (mm == -INFINITY) ? 0.f : mm;
      const float inv = frcp(fmaxf(ll, 1e-30f));
      const float sl = exp2f(-(float)(g * 4 + hq + 1)) * 1.4426950408889634f;
#pragma unroll
      for (int reg = 0; reg < 16; ++reg) {
        int n = nbase + crow(reg, h);
        int dist = t - (16 * n + 31);
        float pv = (dist >= 0) ? __builtin_amdgcn_exp2f(fmaf(s[reg], 1.4426950408889634f, -sl * (float)dist) - m_use) * inv : 0.f;
        ps[reg] += pv;
      }
    }
#pragma unroll
    for (int gq = 0; gq < 4; ++gq) {
      int midx = (nbase >> 2) + 2 * gq + h;
      float hb = 0.5f * ps[4 * gq + 3];
      sImpA[tokl * 129 + midx] = ps[4 * gq] + ps[4 * gq + 1] + ps[4 * gq + 2] + hb;
      if (midx + 1 < 128) sImpB[tokl * 129 + midx + 1] = hb;
    }
  }
  __syncthreads();
  {
    for (int ti = 0; ti < 8; ++ti) {
      const int tok = w * 8 + ti;
      u32 key[2];
#pragma unroll
      for (int hf = 0; hf < 2; ++hf) {
        int j = hf * 64 + l_;
        float v = sImpA[tok * 129 + j] + sImpB[tok * 129 + j];
        if (j > cur) v = -INFINITY;
        if (j == 0 || j == cur || j == cur - 1) v = INFINITY;
        u32 bits = __float_as_uint(v);
        key[hf] = (bits & 0x80000000u) ? ~bits : (bits | 0x80000000u);
      }
      u32 T = 0;
#pragma unroll 4
      for (int bit = 31; bit >= 0; --bit) {
        const u32 cand = T | (1u << bit);
        const int c = __popcll(__ballot(key[0] >= cand)) + __popcll(__ballot(key[1] >= cand));
        if (c >= 16) T = cand;
      }
      const u64 g0 = __ballot(key[0] > T), g1 = __ballot(key[1] > T);
      const u64 e0 = __ballot(key[0] == T), e1 = __ballot(key[1] == T);
      const int need = 16 - (__popcll(g0) + __popcll(g1));
      const u64 below = (1ull << l_) - 1ull;
      const int r0 = __popcll(e0 & below), r1 = __popcll(e0) + __popcll(e1 & below);
      const bool s0 = (key[0] > T) || (key[0] == T && r0 < need);
      const bool s1 = (key[1] > T) || (key[1] == T && r1 < need);
      u64 m0 = __ballot(s0 && l_ <= cur);
      u64 m1 = __ballot(s1 && (64 + l_) <= cur);
      if (l_ == 0) { sSel[tok * 2] = m0; sSel[tok * 2 + 1] = m1; }
    }
  }
  __syncthreads();
  u16* sTot = (u16*)sImpA + w * 2304;
#pragma unroll
  for (int dt = 0; dt < 2; ++dt)
#pragma unroll
    for (int gq = 0; gq < 4; ++gq) {
      uint2 ov; ov.x = ocmp[dt * 8 + 2 * gq]; ov.y = ocmp[dt * 8 + 2 * gq + 1];
      *(uint2*)(sTot + r * 72 + dt * 32 + 8 * gq + 4 * h) = ov;
    }
  const u64 my0 = sSel[tokl * 2], my1 = sSel[tokl * 2 + 1];
  u64 un0 = 0, un1 = 0;
  for (int tk = 0; tk < 64; ++tk) { un0 |= sSel[tk * 2]; un1 |= sSel[tk * 2 + 1]; }
  un0 = ((u64)__builtin_amdgcn_readfirstlane((u32)(un0 >> 32)) << 32) | (u64)__builtin_amdgcn_readfirstlane((u32)un0);
  un1 = ((u64)__builtin_amdgcn_readfirstlane((u32)(un1 >> 32)) << 32) | (u64)__builtin_amdgcn_readfirstlane((u32)un1);
  flash_init(fs);
  {
    const u16* ksrc = P + ((size_t)b * SEQ + lrow) * PW + C_KS + g * 64 + lch;
    const u16* vsrc = vsT + (size_t)lrow * SEQ + lch;
#define KV_STORE2(bb) { u16* k_ = (bb) ? sK2 : sK; u16* v_ = (bb) ? sVT2 : sVT; *(uint4*)(k_ + lrow * 72 + lch) = kr; *(uint4*)(v_ + lrow * 72 + lch) = vr; }
    int j = prev_bit128(un0, un1, cur);
    int jn = (j >= 0) ? prev_bit128(un0, un1, j - 1) : -1;
    if (j >= 0) { kr = *(const uint4*)(ksrc + (size_t)(64 * j) * PW); vr = *(const uint4*)(vsrc + 64 * j); }
    __syncthreads();
    KV_STORE2(0)
    if (jn >= 0) { kr = *(const uint4*)(ksrc + (size_t)(64 * jn) * PW); vr = *(const uint4*)(vsrc + 64 * jn); }
    __syncthreads();
    int bb = 0;
    while (j >= 0) {
      const int jnn = (jn >= 0) ? prev_bit128(un0, un1, jn - 1) : -1;
      if (jn >= 0) KV_STORE2(bb ^ 1)
      if (jnn >= 0) { kr = *(const uint4*)(ksrc + (size_t)(64 * jnn) * PW); vr = *(const uint4*)(vsrc + 64 * jnn); }
      const bool tf = (j < 64) ? ((my0 >> j) & 1) : ((my1 >> (j - 64)) & 1);
      if (__any(tf)) flash_tile<1>(fs, sQrow, bb ? sK2 : sK, bb ? sVT2 : sVT, slope2, t, tmin, 64 * j, 0x40000000, tf, r, h);
      __syncthreads();
      j = jn; jn = jnn; bb ^= 1;
    }
  }
  {
    float inv = g_sel * frcp(fmaxf(fs.l, 1e-30f));
#pragma unroll
    for (int dt = 0; dt < 2; ++dt) {
      uint2 pv[4];
#pragma unroll
      for (int gq = 0; gq < 4; ++gq) pv[gq] = *(const uint2*)(sTot + r * 72 + dt * 32 + 8 * gq + 4 * h);
#pragma unroll
      for (int gq = 0; gq < 4; ++gq) {
        uint2 ov;
        ov.x = pk2(bflo(pv[gq].x) + fs.o[dt][4 * gq + 0] * inv, bfhi(pv[gq].x) + fs.o[dt][4 * gq + 1] * inv);
        ov.y = pk2(bflo(pv[gq].y) + fs.o[dt][4 * gq + 2] * inv, bfhi(pv[gq].y) + fs.o[dt][4 * gq + 3] * inv);
        *(uint2*)(sTot + r * 72 + dt * 32 + 8 * gq + 4 * h) = ov;
      }
    }
  }
  flash_init(fs);
  {
    const int jlo = (t0 >= 511) ? ((t0 - 511) >> 6) : 0;
    const u16* ksrc = P + ((size_t)b * SEQ + lrow) * PW + C_KW + g * 64 + lch;
    const u16* vsrc = vwT + (size_t)lrow * SEQ + lch;
    kr = *(const uint4*)(ksrc + (size_t)(64 * cur) * PW); vr = *(const uint4*)(vsrc + 64 * cur);
    __syncthreads();
    KV_STORE2(0)
    if (cur - 1 >= jlo) { kr = *(const uint4*)(ksrc + (size_t)(64 * (cur - 1)) * PW); vr = *(const uint4*)(vsrc + 64 * (cur - 1)); }
    __syncthreads();
    int bb = 0;
    for (int j = cur; j >= jlo; --j) {
      if (j - 1 >= jlo) KV_STORE2(bb ^ 1)
      if (j - 2 >= jlo) { kr = *(const uint4*)(ksrc + (size_t)(64 * (j - 2)) * PW); vr = *(const uint4*)(vsrc + 64 * (j - 2)); }
      flash_tile<1>(fs, sQrow, bb ? sK2 : sK, bb ? sVT2 : sVT, slope2, t, tmin, 64 * j, 512, true, r, h);
      __syncthreads();
      bb ^= 1;
    }
  }
#undef KV_STORE2
#undef KV_STORE
  {
    float inv = g_win * frcp(fmaxf(fs.l, 1e-30f));
#pragma unroll
    for (int dt = 0; dt < 2; ++dt) {
      uint2 pv[4];
#pragma unroll
      for (int gq = 0; gq < 4; ++gq) pv[gq] = *(const uint2*)(sTot + r * 72 + dt * 32 + 8 * gq + 4 * h);
#pragma unroll
      for (int gq = 0; gq < 4; ++gq) {
        uint2 ov;
        ov.x = pk2(bflo(pv[gq].x) + fs.o[dt][4 * gq + 0] * inv, bfhi(pv[gq].x) + fs.o[dt][4 * gq + 1] * inv);
        ov.y = pk2(bflo(pv[gq].y) + fs.o[dt][4 * gq + 2] * inv, bfhi(pv[gq].y) + fs.o[dt][4 * gq + 3] * inv);
        *(uint2*)(sTot + r * 72 + dt * 32 + 8 * gq + 4 * h) = ov;
      }
    }
  }
#pragma unroll
  for (int i = 0; i < 4; ++i) {
    const int row = (l_ >> 3) + 8 * i, ch = l_ & 7;
    uint4 v = *(const uint4*)(sTot + row * 72 + ch * 8);
    *(uint4*)(P + ((size_t)b * SEQ + t0 + th * 32 + row) * PW + C_NQ + head * 64 + ch * 8) = v;
  }
}

#define VCTX int z_ = 0; asm volatile("" : "+s"(z_)); z_ = __builtin_amdgcn_readfirstlane(z_);                     \
  int t8_ = (wave_id << 6) | (int)__builtin_amdgcn_mbcnt_hi(~0u, __builtin_amdgcn_mbcnt_lo(~0u, 0u));             \
  asm volatile("" : "+v"(t8_)); const int lt_ = t8_ & 255; Ctx q{kp, kp.xf + z_, kp.ws + z_, lt_, t8_};
#define GEMM_TILES(MT, NT, CALL)                                                        \
  {                                                                                     \
    const int nsn_ = (NT) >> 1, ns_ = ((MT) >> 4) * nsn_;                               \
    const int nl_ = nb >> 3; const int xcd_ = bid / nl_, loc_ = bid - xcd_ * nl_;         \
    int sup = xcd_, wi = loc_;                                                          \
    bool primed = false;                                                                \
    GStage gst; gst.w0 = gst.w1 = gst.w2 = gst.w3 = gst.x0 = gst.x1 = gst.x2 = gst.x3 = make_uint4(0, 0, 0, 0); \
    while (sup < ns_ && wi < 32) {                                                      \
      int nsup = sup, nwi = wi + nl_;                                                   \
      if (nwi >= 32) { nwi = loc_; nsup = sup + 8; }                                    \
      const bool has_next = nsup < ns_;                                                 \
      const int sm_ = sup / nsn_, sn_ = sup - sm_ * nsn_;                               \
      const int mt = sm_ * 16 + (wi >> 1), nt = sn_ * 2 + (wi & 1);                     \
      const int smn_ = has_next ? nsup / nsn_ : sm_, snn_ = has_next ? nsup - smn_ * nsn_ : sn_; \
      const int mtn = smn_ * 16 + (nwi >> 1), ntn = snn_ * 2 + (nwi & 1);               \
      { VCTX CALL; }                                                                    \
      primed = has_next;                                                                \
      sup = nsup; wi = nwi;                                                             \
    }                                                                                   \
  }
DI void run_phase(const Params& kp, int ph, char* smem, int wave_id) {
  int bid = blockIdx.x;
  int vb = wave_id >> 2;
  asm volatile("" : "+s"(bid));
  asm volatile("" : "+s"(vb));
  bid = __builtin_amdgcn_readfirstlane(bid);
  vb = __builtin_amdgcn_readfirstlane(vb);
  const int nb = gridDim.x;
  const int vbid = bid * 2 + vb, nvb = nb * 2;
  char* vsm = smem + vb * 73728;
  if (ph == 0) {
    for (int it = vbid; it < N_CONV_TILES + 4096; it += nvb) { VCTX
      if (it < N_CONV_TILES) conv_item(q, 0, it, vsm);
      else ln_rows(q, q.kp.in[0], q.xf, ws_xb(q), q.kp.in[1], q.kp.in[2], it - N_CONV_TILES);
    }
    return;
  }
  const int l = (ph - 1) / 11, s = (ph - 1) % 11;
  switch (s) {
    case 0:
      GEMM_TILES(128, 18, ph_inproj(q, l, mt, nt, mtn, ntn, has_next, primed, gst, smem))
      break;
    case 1: {
      TilePf pf0, pf1;
      for (int it = vbid; it < 2048 + 4096 + 256 + 1024; it += nvb) { VCTX
        const int itn = it + nvb;
        if (it < 2048) hgrn_A(q, l, it, vsm, pf0, pf1, it - nvb >= 0, itn < 2048 ? itn : -1);
        else if (it < 6144) lru_item<false>(q, l, it - 2048, vsm, pf0, pf1, it - nvb >= 2048, itn < 6144 ? itn - 2048 : -1);
        else if (it < 6400) nsa_compress(q, l, it - 6144, vsm);
        else nsa_vtrans(q, it - 6400, vsm);
      }
    } break;
    case 2:
      for (int it = vbid; it < 512; it += nvb) { VCTX hgrn_B(q, it); }
      if (vbid >= nvb - 8) { VCTX lru_B(q, vbid - (nvb - 8)); }
      for (int it = bid; it < 1024; it += nb) { VCTX nsa_attn(q, it, smem); }
      break;
    case 3: {
      TilePf pf0, pf1, pf2;
      for (int it = vbid; it < 2048 + 4096; it += nvb) { VCTX
        const int itn = it + nvb;
        if (it < 2048) hgrn_C(q, l, it, vsm, pf0, pf1, pf2, it - nvb >= 0, itn < 2048 ? itn : -1);
        else lru_item<true>(q, l, it - 2048, vsm, pf0, pf1, it - nvb >= 2048, itn < 6144 ? itn - 2048 : -1);
      }
    } break;
    case 4:
      GEMM_TILES(128, 8, ph_merge(q, l, mt, nt, mtn, ntn, has_next, primed, gst, smem))
      break;
    case 5:
      GEMM_TILES(128, 4, ph_resid_gemm(q, ws_W(q) + W_OUT, 1024, ws_HS(q), 1024, 1024, mt, nt, mtn, ntn, has_next, primed, gst, smem))
      break;
    case 6:
      for (int it = vbid; it < 4096; it += nvb) { VCTX ln_rows(q, q.xf, q.xf, ws_xb(q), q.kp.in[24] + l * 1024, q.kp.in[25] + l * 1024, it); }
      break;
    case 7:
      for (int wi = bid * 8 + wave_id; wi < 704; wi += nb * 8) { VCTX ph_halo(q, wi); }
      break;
    case 8:
      GEMM_TILES(128, 22, ph_ffnup(q, l, mt, nt, mtn, ntn, has_next, primed, gst, smem))
      break;
    case 9:
      GEMM_TILES(128, 4, ph_resid_gemm(q, ws_W(q) + W_DOWN, FF, ws_P(q), FF, FF, mt, nt, mtn, ntn, has_next, primed, gst, smem))
      break;
    case 10: {
      const int nconv = (l + 1 < 2) ? N_CONV_TILES : 0;
      for (int it = vbid; it < 4096 + nconv; it += nvb) { VCTX
        if (it < 4096) ln_rows(q, q.xf, q.xf, ws_xb(q), q.kp.in[30] + l * 1024, q.kp.in[31] + l * 1024, it);
        else conv_item(q, l + 1, it - 4096, vsm);
      }
    } break;
  }
}

DI void grid_barrier(unsigned* bar, unsigned target) {
  asm volatile("s_waitcnt vmcnt(0)" ::: "memory");
  __syncthreads();
  if (threadIdx.x == 0) {
    __builtin_amdgcn_fence(__ATOMIC_RELEASE, "agent");
    asm volatile("s_waitcnt vmcnt(0)" ::: "memory");
    __hip_atomic_fetch_add(bar, 1u, __ATOMIC_RELAXED, __HIP_MEMORY_SCOPE_AGENT);
    unsigned spins = 0;
    while (__hip_atomic_load(bar, __ATOMIC_RELAXED, __HIP_MEMORY_SCOPE_AGENT) < target) {
      __builtin_amdgcn_s_sleep(1);
      if (++spins > (1u << 24)) break;
    }
    __builtin_amdgcn_fence(__ATOMIC_ACQUIRE, "agent");
    asm volatile("s_waitcnt vmcnt(0)" ::: "memory");
  }
  __syncthreads();
}

__global__ void __launch_bounds__(512, 2) mega_kernel(Params p) {
  __shared__ __attribute__((aligned(16))) char smem[SMEM_BYTES];
  cg::grid_group grid = cg::this_grid();
  unsigned nbar = 0;
  const int wave_id = __builtin_amdgcn_readfirstlane((int)(threadIdx.x >> 6));
  for (int ph = p.ph_lo; ph < p.ph_hi; ++ph) {
    run_phase(p, ph, smem, wave_id);
    if (ph + 1 < p.ph_hi) {
      if (ph == p.ph_lo) grid.sync();
      else { ++nbar; grid_barrier((unsigned*)(p.ws + OFF_BAR), nbar * gridDim.x); }
    }
  }
}

extern "C" void kernel_launch(void* const* d_in, const int* in_sizes, int n_in, void* d_out, int out_size,
                              void* d_ws, size_t ws_size, hipStream_t stream) {
  static int grid_blocks = 0;
  if (!grid_blocks) {
    int dev = 0, cus = 0, per_cu = 0;
    (void)hipGetDevice(&dev);
    (void)hipDeviceGetAttribute(&cus, hipDeviceAttributeMultiprocessorCount, dev);
    (void)hipOccupancyMaxActiveBlocksPerMultiprocessor(&per_cu, mega_kernel, 512, 0);
    if (per_cu > 1) per_cu = 1;
    if (per_cu < 1) per_cu = 1;
    grid_blocks = cus * per_cu;
    grid_blocks -= grid_blocks % 8;
  }
  (void)hipMemsetAsync((char*)d_ws + OFF_BAR, 0, 256, stream);
  Params p{};
  for (int i = 0; i < 32; ++i) p.in[i] = (const float*)d_in[i];
  p.xf = (float*)d_out;
  p.ws = (char*)d_ws;
#if MULTI_LAUNCH
  for (int ph = 0; ph < NPHASE; ++ph) {
    p.ph_lo = ph; p.ph_hi = ph + 1;
    void* args[] = {&p};
    hipError_t e = hipLaunchCooperativeKernel((void*)mega_kernel, dim3(grid_blocks), dim3(512), args, 0, stream);
    if (e != hipSuccess) fprintf(stderr, "launch failed: %s\n", hipGetErrorString(e));
  }
#else
  p.ph_lo = 0; p.ph_hi = NPHASE;
  void* args[] = {&p};
  hipError_t e = hipLaunchCooperativeKernel((void*)mega_kernel, dim3(grid_blocks), dim3(512), args, 0, stream);
  if (e != hipSuccess) fprintf(stderr, "cooperative launch failed: %s (grid %d)\n", hipGetErrorString(e), grid_blocks);
#endif
}
```

```cpp
#include <hip/hip_runtime.h>
#include <hip/hip_cooperative_groups.h>
#include <cstdio>
namespace cg = cooperative_groups;

#ifndef MULTI_LAUNCH
#define MULTI_LAUNCH 0
#endif

#define DI __device__ __forceinline__
typedef unsigned short u16;
typedef unsigned int u32;
typedef unsigned long long u64;
typedef __attribute__((ext_vector_type(8))) short bf16x8;
typedef __attribute__((ext_vector_type(4))) short bf16x4;
typedef __attribute__((ext_vector_type(16))) float f32x16;
typedef __attribute__((ext_vector_type(2))) __bf16 bf2_t;

#define MFMA32(a, b, c) __builtin_amdgcn_mfma_f32_32x32x16_bf16((a), (b), (c), 0, 0, 0)

constexpr int NTOK = 32768, SEQ = 8192, PW = 4480, INDIM = 7448, FF = 2816;
constexpr int C_HQ = 0, C_HF = 512, C_HI = 1024, C_HG = 1536, C_NQ = 2048, C_KC = 2560, C_VC = 2688,
              C_KS = 2816, C_VS = 2944, C_KW = 3072, C_VW = 3200, C_NG = 3328, C_LX = 3352, C_LY = 3864, C_MG = 4376;
constexpr size_t OFF_XB = 0;
constexpr size_t OFF_R1 = 67108864;
constexpr size_t OFF_HS = OFF_R1 + 293601280;
constexpr size_t OFF_VST = OFF_HS + 67108864;
constexpr size_t OFF_W = OFF_R1 + 369098752;
constexpr size_t OFF_VWT = OFF_W + 38060032;
constexpr size_t OFF_DEC = OFF_VWT + 8388608;
constexpr size_t OFF_KCG = OFF_DEC + 1048576;
constexpr size_t OFF_VCT = OFF_KCG + 524288;
constexpr size_t OFF_CARA = OFF_VCT + 524288;
constexpr size_t OFF_CARH = OFF_CARA + 2097152;
constexpr size_t OFF_CARI = OFF_CARH + 2097152;
constexpr size_t OFF_BAR = OFF_CARI + 2097152;
constexpr size_t OFF_HALO = OFF_BAR + 4096;
constexpr size_t OFF_W1F = OFF_HALO + 2097152;
constexpr size_t OFF_PEV = OFF_W1F + 524288;
constexpr int W_IN = 0, W_BR = 7626752, W_OUT = 9199616, W_UP = 10248192, W_DOWN = 16015360, W_LA = 18898944, W_LX = 18964480;
constexpr int N_CONV_TILES = 1872 + 384 + 256 + 1408 + 704 + 32 + 64 + 2;
constexpr int NPHASE = 23;
constexpr float ALPHA = 1.41421356237f;
constexpr int SMEM_BYTES = 147456;

struct Params {
  const float* in[32];
  float* xf;
  char* ws;
  int ph_lo, ph_hi;
};
template <class T> DI T* as_global(T* q) { return (T*)(__attribute__((address_space(1))) T*)q; }
struct Ctx {
  const Params& kp;
  float* xf;
  char* ws;
  int tid;
  int tid8;
};

DI u32 pk2(float a, float b) { bf2_t v; v[0] = (__bf16)a; v[1] = (__bf16)b; return __builtin_bit_cast(u32, v); }
DI u16 f2bf(float a) { __bf16 v = (__bf16)a; return __builtin_bit_cast(u16, v); }
DI float bf2f(u16 v) { return __uint_as_float(((u32)v) << 16); }
DI float bflo(u32 v) { return __uint_as_float(v << 16); }
DI float bfhi(u32 v) { return __uint_as_float(v & 0xffff0000u); }
DI int crow(int reg, int h) { return (reg & 3) + 8 * (reg >> 2) + 4 * h; }
DI f32x16 zero16() { f32x16 z;
#pragma unroll
  for (int i = 0; i < 16; ++i) z[i] = 0.f; return z; }
template <int S> DI bf16x8 pack8(const f32x16& x) {
  uint4 u;
  u.x = pk2(x[8 * S + 0], x[8 * S + 1]); u.y = pk2(x[8 * S + 2], x[8 * S + 3]);
  u.z = pk2(x[8 * S + 4], x[8 * S + 5]); u.w = pk2(x[8 * S + 6], x[8 * S + 7]);
  return __builtin_bit_cast(bf16x8, u);
}
DI bf16x8 cat4(bf16x4 lo, bf16x4 hi) { return __builtin_shufflevector(lo, hi, 0, 1, 2, 3, 4, 5, 6, 7); }
DI float wave_sum(float v) {
#pragma unroll
  for (int o = 32; o > 0; o >>= 1) v += __shfl_xor(v, o);
  return v;
}
DI float frcp(float x) { return __builtin_amdgcn_rcpf(x); }
DI float sigmoidf_(float x) { return frcp(1.f + __expf(-x)); }
DI float gelu_t(float x) {
  float z = 0.7978845608028654f * (x + 0.044715f * x * x * x);
  float e = __expf(2.f * z);
  float th = 1.f - 2.f * frcp(e + 1.f);
  return 0.5f * x * (1.f + th);
}

DI u16* ws_xb(const Ctx& p) { return (u16*)(p.ws + OFF_XB); }
DI u16* ws_P(const Ctx& p) { return (u16*)(p.ws + OFF_R1); }
DI u16* ws_HS(const Ctx& p) { return (u16*)(p.ws + OFF_HS); }
DI u16* ws_W(const Ctx& p) { return (u16*)(p.ws + OFF_W); }

DI void convT_tile(const Ctx& p, const float* __restrict__ src, int K, int N, u16* __restrict__ dst, int tile, char* smem) {
  float* t = (float*)smem;
  int ntn = (N + 63) >> 6;
  int kt = tile / ntn, nt = tile - kt * ntn;
  int k0 = kt * 64, n0 = nt * 64;
  int tid = p.tid, c = tid & 63, r4 = tid >> 6;
  __syncthreads();
  float ld[16];
#pragma unroll
  for (int i = 0; i < 16; ++i) {
    int r = r4 + 4 * i; int n = n0 + c;
    ld[i] = (n < N) ? src[(size_t)(k0 + r) * N + n] : 0.f;
  }
#pragma unroll
  for (int i = 0; i < 16; ++i) t[(r4 + 4 * i) * 65 + c] = ld[i];
  __syncthreads();
  const int c4 = tid & 15, rr = tid >> 4;
#pragma unroll
  for (int i = 0; i < 4; ++i) {
    int r = rr + 16 * i; int n = n0 + r;
    uint2 o;
    o.x = pk2(t[(4 * c4 + 0) * 65 + r], t[(4 * c4 + 1) * 65 + r]);
    o.y = pk2(t[(4 * c4 + 2) * 65 + r], t[(4 * c4 + 3) * 65 + r]);
    if (n < N) *(uint2*)(dst + (size_t)n * K + k0 + 4 * c4) = o;
  }
}
DI void conv_item(const Ctx& p, int l, int idx, char* smem) {
  u16* W = ws_W(p);
  if (idx < 1872) { convT_tile(p, p.kp.in[3] + (size_t)l * 1024 * INDIM, 1024, INDIM, W + W_IN, idx, smem); return; }
  idx -= 1872;
  if (idx < 384) { int br = idx >> 7; convT_tile(p, p.kp.in[20 + br] + (size_t)l * 512 * 1024, 512, 1024, W + W_BR + br * 524288, idx & 127, smem); return; }
  idx -= 384;
  if (idx < 256) { convT_tile(p, p.kp.in[23] + (size_t)l * 1024 * 1024, 1024, 1024, W + W_OUT, idx, smem); return; }
  idx -= 256;
  if (idx < 1408) { convT_tile(p, p.kp.in[26] + (size_t)l * 1024 * 5632, 1024, 5632, W + W_UP, idx, smem); return; }
  idx -= 1408;
  if (idx < 704) { convT_tile(p, p.kp.in[29] + (size_t)l * FF * 1024, FF, 1024, W + W_DOWN, idx, smem); return; }
  idx -= 704;
  if (idx < 32) {
    int which = idx >> 4, g = (idx >> 2) & 3, tl = idx & 3;
    convT_tile(p, p.kp.in[which ? 17 : 15] + (size_t)(l * 4 + g) * 16384, 128, 128, W + (which ? W_LX : W_LA) + g * 16384, tl, smem);
    return;
  }
  idx -= 32;
  if (idx < 64) {
    const int kv = idx >> 5, part = idx & 31;
    const float* w1 = p.kp.in[kv ? 11 : 8] + (size_t)l * 2048 * 64;
    u16* dst = (u16*)(p.ws + OFF_W1F) + (size_t)kv * 131072;
    __syncthreads();
    const int j = p.tid & 63;
#pragma unroll 4
    for (int i = 0; i < 16; ++i) {
      const int k = part * 64 + (p.tid >> 6) + 4 * i;
      const float v = w1[(size_t)k * 64 + j];
      dst[(((j >> 5) * 128 + (k >> 4)) * 64 + (j & 31) + 32 * ((k >> 3) & 1)) * 8 + (k & 7)] = f2bf(v);
    }
    __syncthreads();
    return;
  }
  idx -= 64;
  {
    const int kv = idx;
    const float* w1 = p.kp.in[kv ? 11 : 8] + (size_t)l * 2048 * 64;
    const float* pe = p.kp.in[kv ? 10 : 7] + (size_t)l * 2048;
    float* red = (float*)smem;
    const int j = p.tid & 63, ks = p.tid >> 6;
    float a = 0.f;
#pragma unroll 8
    for (int k = ks * 512; k < ks * 512 + 512; ++k) a += pe[k] * w1[(size_t)k * 64 + j];
    __syncthreads();
    red[ks * 64 + j] = a;
    __syncthreads();
    if (p.tid < 64) ((float*)(p.ws + OFF_PEV))[kv * 64 + p.tid] = red[p.tid] + red[64 + p.tid] + red[128 + p.tid] + red[192 + p.tid];
  }
}

DI void ln_rows(const Ctx& p, const float* src, float* dstf, u16* dstb, const float* __restrict__ g, const float* __restrict__ bta, int item) {
  const int w = p.tid >> 6, l = p.tid & 63;
  const size_t row0 = (size_t)item * 8 + w, row1 = row0 + 4;
  const float4* sa = (const float4*)(src + row0 * 1024);
  const float4* sb = (const float4*)(src + row1 * 1024);
  float4 va[4], vb[4]; float suma = 0.f, sumb = 0.f;
#pragma unroll
  for (int i = 0; i < 4; ++i) { va[i] = sa[l + 64 * i]; vb[i] = sb[l + 64 * i]; }
#pragma unroll
  for (int i = 0; i < 4; ++i) { suma += va[i].x + va[i].y + va[i].z + va[i].w; sumb += vb[i].x + vb[i].y + vb[i].z + vb[i].w; }
  suma = wave_sum(suma); sumb = wave_sum(sumb);
  const float mua = suma * (1.f / 1024.f), mub = sumb * (1.f / 1024.f);
  float vsa = 0.f, vsb = 0.f;
#pragma unroll
  for (int i = 0; i < 4; ++i) {
    float a = va[i].x - mua, b = va[i].y - mua, c = va[i].z - mua, d = va[i].w - mua;
    vsa += a * a + b * b + c * c + d * d;
    float e = vb[i].x - mub, f = vb[i].y - mub, gg = vb[i].z - mub, hh = vb[i].w - mub;
    vsb += e * e + f * f + gg * gg + hh * hh;
  }
  vsa = wave_sum(vsa); vsb = wave_sum(vsb);
  const float rsa = rsqrtf(vsa * (1.f / 1024.f) + 1e-5f), rsb = rsqrtf(vsb * (1.f / 1024.f) + 1e-5f);
#pragma unroll
  for (int i = 0; i < 4; ++i) {
    const int ci = l + 64 * i;
    const float4 gv = ((const float4*)g)[ci], bv = ((const float4*)bta)[ci];
    float4 o;
    o.x = (va[i].x - mua) * rsa * gv.x + bv.x; o.y = (va[i].y - mua) * rsa * gv.y + bv.y;
    o.z = (va[i].z - mua) * rsa * gv.z + bv.z; o.w = (va[i].w - mua) * rsa * gv.w + bv.w;
    ((float4*)(dstf + row0 * 1024))[ci] = o;
    uint2 pk; pk.x = pk2(o.x, o.y); pk.y = pk2(o.z, o.w);
    ((uint2*)(dstb + row0 * 1024))[ci] = pk;
    o.x = (vb[i].x - mub) * rsb * gv.x + bv.x; o.y = (vb[i].y - mub) * rsb * gv.y + bv.y;
    o.z = (vb[i].z - mub) * rsb * gv.z + bv.z; o.w = (vb[i].w - mub) * rsb * gv.w + bv.w;
    ((float4*)(dstf + row1 * 1024))[ci] = o;
    pk.x = pk2(o.x, o.y); pk.y = pk2(o.z, o.w);
    ((uint2*)(dstb + row1 * 1024))[ci] = pk;
  }
}

struct GStage { uint4 w0, w1, w2, w3, x0, x1, x2, x3; };
struct GOp { const u16* W; const u16* X; int ldw, ldx, K; unsigned wr1, wr2, wr3; };
DI void op_rows(GOp& o) { o.wr1 = 128u * (unsigned)o.ldw; o.wr2 = 2u * o.wr1; o.wr3 = 3u * o.wr1; }

template <int NI, int MI>
DI void gemm8(const Ctx& p, const GOp& op, const GOp& nx, bool has_next, bool primed, GStage& g, f32x16 (&acc)[NI][MI], char* smem) {
  constexpr int WR = NI * 64, XR = MI * 128, STG = (WR + XR) * 72;
  u16* sW = (u16*)smem;
  u16* sX = sW + WR * 72;
  const int tid = p.tid8, l = tid & 63, w = tid >> 6;
  const int wn = w & 1, wm = w >> 1, r = l & 31, h = l >> 5;
  const int lr = tid >> 3, lc = tid & 7;
#define G_LOAD(O, ko)                                                                      \
  {                                                                                        \
      \
    const char* wb_ = (const char*)(O).W; const char* xb_ = (const char*)(O).X;            \
    const unsigned wo_ = ((unsigned)lr * (unsigned)(O).ldw + (unsigned)(lc * 8 + (ko))) * 2u; \
    const unsigned xo_ = ((unsigned)lr * (unsigned)(O).ldx + (unsigned)(lc * 8 + (ko))) * 2u; \
    const unsigned xs_ = 128u * (unsigned)(O).ldx;                                         \
    g.w0 = *(const uint4*)(wb_ + wo_);                                                     \
    g.w1 = *(const uint4*)(wb_ + (wo_ + (O).wr1));                                         \
    if (NI == 4) {                                                                         \
      g.w2 = *(const uint4*)(wb_ + (wo_ + (O).wr2));                                       \
      g.w3 = *(const uint4*)(wb_ + (wo_ + (O).wr3));                                       \
    }                                                                                      \
    g.x0 = *(const uint4*)(xb_ + xo_);                                                     \
    g.x1 = *(const uint4*)(xb_ + (xo_ + xs_));                                             \
    if (MI == 2) {                                                                         \
      g.x2 = *(const uint4*)(xb_ + (xo_ + 2u * xs_));                                      \
      g.x3 = *(const uint4*)(xb_ + (xo_ + 3u * xs_));                                      \
    }                                                                                      \
  }
#define G_STORE(st)                                                    \
  {                                                                    \
    u16* bw_ = sW + (st) * STG; u16* bx_ = sX + (st) * STG;            \
    *(uint4*)(bw_ + (lr) * 72 + lc * 8) = g.w0;                        \
    *(uint4*)(bw_ + (lr + 64) * 72 + lc * 8) = g.w1;                   \
    if (NI == 4) {                                                     \
      *(uint4*)(bw_ + (lr + 128) * 72 + lc * 8) = g.w2;                \
      *(uint4*)(bw_ + (lr + 192) * 72 + lc * 8) = g.w3;                \
    }                                                                  \
    *(uint4*)(bx_ + (lr) * 72 + lc * 8) = g.x0;                        \
    *(uint4*)(bx_ + (lr + 64) * 72 + lc * 8) = g.x1;                   \
    if (MI == 2) {                                                     \
      *(uint4*)(bx_ + (lr + 128) * 72 + lc * 8) = g.x2;                \
      *(uint4*)(bx_ + (lr + 192) * 72 + lc * 8) = g.x3;                \
    }                                                                  \
  }
  if (!primed) {
    G_LOAD(op, 0)
    __syncthreads();
    G_STORE(0)
    G_LOAD(op, 64)
    __syncthreads();
  }
  const int KT = op.K >> 6;
#pragma unroll 1
  for (int kt = 0; kt < KT; ++kt) {
    const int cur = kt & 1;
    if (kt + 1 < KT || has_next) { G_STORE(cur ^ 1) }
    if (kt + 2 < KT) { G_LOAD(op, (kt + 2) * 64) }
    else if (has_next) { G_LOAD(nx, (kt + 2 - KT) * 64) }
    const u16* cw = sW + cur * STG + (wn * (NI * 32) + r) * 72 + h * 8;
    const u16* cx = sX + cur * STG + (wm * (MI * 32) + r) * 72 + h * 8;
    bf16x8 fa0[NI], fb0[MI], fa1[NI], fb1[MI];
#define F_LOAD(FA, FB, ks)                                                                         \
  _Pragma("unroll") for (int ni = 0; ni < NI; ++ni) FA[ni] = *(const bf16x8*)(cw + ni * 32 * 72 + (ks) * 16); \
  _Pragma("unroll") for (int mi = 0; mi < MI; ++mi) FB[mi] = *(const bf16x8*)(cx + mi * 32 * 72 + (ks) * 16);
#define F_MMA(FA, FB)                                                                              \
  _Pragma("unroll") for (int ni = 0; ni < NI; ++ni)                                                \
  _Pragma("unroll") for (int mi = 0; mi < MI; ++mi) acc[ni][mi] = MFMA32(FA[ni], FB[mi], acc[ni][mi]);
    F_LOAD(fa0, fb0, 0)
    F_LOAD(fa1, fb1, 1)
    __builtin_amdgcn_sched_barrier(0);
    F_MMA(fa0, fb0)
    __builtin_amdgcn_sched_barrier(0);
    F_LOAD(fa0, fb0, 2)
    __builtin_amdgcn_sched_barrier(0);
    F_MMA(fa1, fb1)
    __builtin_amdgcn_sched_barrier(0);
    F_LOAD(fa1, fb1, 3)
    __builtin_amdgcn_sched_barrier(0);
    F_MMA(fa0, fb0)
    __builtin_amdgcn_sched_barrier(0);
    F_MMA(fa1, fb1)
#undef F_LOAD
#undef F_MMA
    __syncthreads();
  }
#undef G_LOAD
#undef G_STORE
}

#define EPI_GEOM(NI_, MI_)                                                              \
  const int l_ = p.tid8 & 63, w_ = p.tid8 >> 6;                                         \
  const int nb_ = (w_ & 1) * (NI_ * 32) + 4 * (l_ >> 5), mb_ = (w_ >> 1) * (MI_ * 32) + (l_ & 31);

template <bool BIAS>
DI void epi_rows_bf16(const Ctx& p, f32x16 (&acc)[4][2], const float* bias_n0, u16* out_m0n0, unsigned ldo, int nvalid, char* smem) {
  const int l_ = p.tid8 & 63, w_ = p.tid8 >> 6, r_ = l_ & 31, h_ = l_ >> 5;
  const int wn_ = w_ & 1, wm_ = w_ >> 1;
  u16* sl = (u16*)(smem + 73728 + w_ * 9216);
#pragma unroll
  for (int half = 0; half < 2; ++half) {
#pragma unroll
    for (int ni2 = 0; ni2 < 2; ++ni2) {
      const int ni = 2 * half + ni2;
#pragma unroll
      for (int gq = 0; gq < 4; ++gq) {
        float4 bv = make_float4(0.f, 0.f, 0.f, 0.f);
        if (BIAS) bv = *(const float4*)(bias_n0 + wn_ * 128 + ni * 32 + 8 * gq + 4 * h_);
#pragma unroll
        for (int mi = 0; mi < 2; ++mi) {
          uint2 o;
          o.x = pk2(acc[ni][mi][4 * gq + 0] + bv.x, acc[ni][mi][4 * gq + 1] + bv.y);
          o.y = pk2(acc[ni][mi][4 * gq + 2] + bv.z, acc[ni][mi][4 * gq + 3] + bv.w);
          *(uint2*)(sl + (mi * 32 + r_) * 72 + ni2 * 32 + 8 * gq + 4 * h_) = o;
        }
      }
    }
#pragma unroll
    for (int i = 0; i < 8; ++i) {
      const int row = (l_ >> 3) + 8 * i, ch = l_ & 7;
      uint4 v = *(const uint4*)(sl + row * 72 + ch * 8);
      const int n = wn_ * 128 + half * 64 + ch * 8;
      if (n < nvalid) *(uint4*)((char*)out_m0n0 + ((unsigned)(wm_ * 64 + row) * ldo + (unsigned)n) * 2u) = v;
    }
  }
  __syncthreads();
}

DI GOp op_inproj(const Ctx& p, int mt, int nt) { GOp o; o.W = ws_W(p) + W_IN + (size_t)(nt * 256) * 1024; o.X = ws_xb(p) + (size_t)(mt * 256) * 1024; o.ldw = 1024; o.ldx = 1024; o.K = 1024; op_rows(o); return o; }
DI void ph_inproj(const Ctx& p, int l, int mt, int nt, int mtn, int ntn, bool has_next, bool primed, GStage& g, char* smem) {
  const int n0 = nt * 256, m0 = mt * 256;
  f32x16 acc[4][2];
#pragma unroll
  for (int i = 0; i < 4; ++i)
#pragma unroll
    for (int j = 0; j < 2; ++j) acc[i][j] = zero16();
  gemm8<4, 2>(p, op_inproj(p, mt, nt), op_inproj(p, mtn, ntn), has_next, primed, g, acc, smem);
  const float* bias = p.kp.in[4] + (size_t)l * INDIM;
  epi_rows_bf16<true>(p, acc, bias + n0, ws_P(p) + (size_t)m0 * PW + n0, PW, PW - n0, smem);
}

DI GOp op_merge(const Ctx& p, int mt, int nt, int sq) {
  const int br = sq >> 1; GOp o;
  if ((sq & 1) == 0) { o.W = ws_W(p) + W_IN + (size_t)(C_MG + br * 1024 + nt * 128) * 1024; o.X = ws_xb(p) + (size_t)(mt * 256) * 1024; o.ldw = 1024; o.ldx = 1024; o.K = 1024; }
  else { o.W = ws_W(p) + W_BR + br * 524288 + (size_t)(nt * 128) * 512; o.X = ws_P(p) + (size_t)(mt * 256) * PW + (br == 0 ? C_HQ : (br == 1 ? C_NQ : C_LY)); o.ldw = 512; o.ldx = PW; o.K = 512; }
  op_rows(o);
  return o;
}
DI void ph_merge(const Ctx& p, int l, int mt, int nt, int mtn, int ntn, bool has_next, bool primed, GStage& g, char* smem) {
  const int n0 = nt * 128, m0 = mt * 256;
  const u16* P = ws_P(p);
  u16* M = ws_HS(p);
  EPI_GEOM(2, 2)
#pragma unroll 1
  for (int br = 0; br < 3; ++br) {
    f32x16 ga[2][2];
#pragma unroll
    for (int i = 0; i < 2; ++i)
#pragma unroll
      for (int j = 0; j < 2; ++j) ga[i][j] = zero16();
    gemm8<2, 2>(p, op_merge(p, mt, nt, 2 * br), op_merge(p, mt, nt, 2 * br + 1), true, primed || br > 0, g, ga, smem);
    const float* bias = p.kp.in[4] + (size_t)l * INDIM + C_MG + br * 1024;
    u32 sg0[2][8];
    uint4* sgl = (uint4*)(smem + 110592 + w_ * 4096) + l_;
#pragma unroll
    for (int ni = 0; ni < 2; ++ni) {
      u32 sv[2][8];
#pragma unroll
      for (int gq = 0; gq < 4; ++gq) {
        float4 bv = *(const float4*)(bias + n0 + nb_ + ni * 32 + 8 * gq);
#pragma unroll
        for (int mi = 0; mi < 2; ++mi) {
          sv[mi][2 * gq + 0] = pk2(sigmoidf_(ga[ni][mi][4 * gq + 0] + bv.x), sigmoidf_(ga[ni][mi][4 * gq + 1] + bv.y));
          sv[mi][2 * gq + 1] = pk2(sigmoidf_(ga[ni][mi][4 * gq + 2] + bv.z), sigmoidf_(ga[ni][mi][4 * gq + 3] + bv.w));
        }
      }
      if (ni == 0) {
#pragma unroll
        for (int mi = 0; mi < 2; ++mi)
#pragma unroll
          for (int e = 0; e < 8; ++e) sg0[mi][e] = sv[mi][e];
      } else {
#pragma unroll
        for (int mi = 0; mi < 2; ++mi)
#pragma unroll
          for (int q = 0; q < 2; ++q) sgl[(mi * 2 + q) * 64] = make_uint4(sv[mi][4 * q], sv[mi][4 * q + 1], sv[mi][4 * q + 2], sv[mi][4 * q + 3]);
      }
    }
#pragma unroll
    for (int i = 0; i < 2; ++i)
#pragma unroll
      for (int j = 0; j < 2; ++j) ga[i][j] = zero16();
    gemm8<2, 2>(p, op_merge(p, mt, nt, 2 * br + 1), (br < 2) ? op_merge(p, mt, nt, 2 * br + 2) : op_merge(p, mtn, ntn, 0), (br < 2) || has_next, true, g, ga, smem);
    {
      int ll = l_;
      asm volatile("" : "+v"(ll));
      u16* sl = (u16*)(smem + 55296 + w_ * 5120);
      const int r_ = ll & 31, h_ = ll >> 5, wn_ = w_ & 1, wm_ = w_ >> 1;
#pragma unroll
      for (int ni = 0; ni < 2; ++ni) {
        u32 sv[2][8];
#pragma unroll
        for (int mi = 0; mi < 2; ++mi) {
          if (ni == 0) {
#pragma unroll
            for (int e = 0; e < 8; ++e) sv[mi][e] = sg0[mi][e];
          } else {
#pragma unroll
            for (int q = 0; q < 2; ++q) {
              const uint4 t4 = sgl[(mi * 2 + q) * 64];
              sv[mi][4 * q] = t4.x; sv[mi][4 * q + 1] = t4.y; sv[mi][4 * q + 2] = t4.z; sv[mi][4 * q + 3] = t4.w;
            }
          }
        }
#pragma unroll
        for (int mi = 0; mi < 2; ++mi)
#pragma unroll
          for (int gq = 0; gq < 4; ++gq) {
            uint2 o;
            o.x = pk2(bflo(sv[mi][2 * gq]) * ga[ni][mi][4 * gq + 0], bfhi(sv[mi][2 * gq]) * ga[ni][mi][4 * gq + 1]);
            o.y = pk2(bflo(sv[mi][2 * gq + 1]) * ga[ni][mi][4 * gq + 2], bfhi(sv[mi][2 * gq + 1]) * ga[ni][mi][4 * gq + 3]);
            *(uint2*)(sl + (mi * 32 + r_) * 40 + 8 * gq + 4 * h_) = o;
          }
        uint4 vv[4], pv[4];
#pragma unroll
        for (int i = 0; i < 4; ++i) {
          const int row = (ll >> 2) + 16 * i, ch = ll & 3;
          vv[i] = *(const uint4*)(sl + row * 40 + ch * 8);
          pv[i] = make_uint4(0, 0, 0, 0);
          if (br > 0) pv[i] = *(const uint4*)((const char*)M + (((unsigned)(m0 + wm_ * 64 + row)) * 1024u + (unsigned)(n0 + wn_ * 64 + ni * 32 + ch * 8)) * 2u);
        }
#pragma unroll
        for (int i = 0; i < 4; ++i) {
          const int row = (ll >> 2) + 16 * i, ch = ll & 3;
          uint4 v = vv[i];
          if (br > 0) {
            v.x = pk2(bflo(pv[i].x) + bflo(v.x), bfhi(pv[i].x) + bfhi(v.x)); v.y = pk2(bflo(pv[i].y) + bflo(v.y), bfhi(pv[i].y) + bfhi(v.y));
            v.z = pk2(bflo(pv[i].z) + bflo(v.z), bfhi(pv[i].z) + bfhi(v.z)); v.w = pk2(bflo(pv[i].w) + bflo(v.w), bfhi(pv[i].w) + bfhi(v.w));
          }
          *(uint4*)((char*)M + (((unsigned)(m0 + wm_ * 64 + row)) * 1024u + (unsigned)(n0 + wn_ * 64 + ni * 32 + ch * 8)) * 2u) = v;
        }
      }
      __syncthreads();
    }
  }
}

DI GOp op_resid(const u16* Wt, int ldw, const u16* X, int ldx, int K, int mt, int nt) { GOp o; o.W = Wt + (size_t)(nt * 256) * ldw; o.X = X + (size_t)(mt * 256) * ldx; o.ldw = ldw; o.ldx = ldx; o.K = K; op_rows(o); return o; }
DI void ph_resid_gemm(const Ctx& p, const u16* Wt, int ldw, const u16* X, int ldx, int K, int mt, int nt, int mtn, int ntn, bool has_next, bool primed, GStage& g, char* smem) {
  const int n0 = nt * 256, m0 = mt * 256;
  f32x16 acc[4][2];
#pragma unroll
  for (int i = 0; i < 4; ++i)
#pragma unroll
    for (int j = 0; j < 2; ++j) acc[i][j] = zero16();
  gemm8<4, 2>(p, op_resid(Wt, ldw, X, ldx, K, mt, nt), op_resid(Wt, ldw, X, ldx, K, mtn, ntn), has_next, primed, g, acc, smem);
  {
    const int l_ = p.tid8 & 63, w_ = p.tid8 >> 6, r_ = l_ & 31, h_ = l_ >> 5, wn_ = w_ & 1, wm_ = w_ >> 1;
    float* sl = (float*)(smem + 73728 + w_ * 9216);
    char* xb = (char*)p.xf;
#pragma unroll
    for (int ni = 0; ni < 4; ++ni) {
#pragma unroll
      for (int mi = 0; mi < 2; ++mi)
#pragma unroll
        for (int gq = 0; gq < 4; ++gq)
          *(float4*)(sl + (mi * 32 + r_) * 36 + 8 * gq + 4 * h_) =
              make_float4(acc[ni][mi][4 * gq + 0], acc[ni][mi][4 * gq + 1], acc[ni][mi][4 * gq + 2], acc[ni][mi][4 * gq + 3]);
#pragma unroll
      for (int i4 = 0; i4 < 8; i4 += 4) {
        float4 xs[4], vs[4];
#pragma unroll
        for (int i = 0; i < 4; ++i) {
          const int row = (l_ >> 3) + 8 * (i4 + i), ch = l_ & 7;
          vs[i] = *(const float4*)(sl + row * 36 + ch * 4);
          xs[i] = *(const float4*)(xb + (((unsigned)(m0 + wm_ * 64 + row)) * 1024u + (unsigned)(n0 + wn_ * 128 + ni * 32 + ch * 4)) * 4u);
        }
#pragma unroll
        for (int i = 0; i < 4; ++i) {
          const int row = (l_ >> 3) + 8 * (i4 + i), ch = l_ & 7;
          float4 x = xs[i];
          x.x = ALPHA * x.x + vs[i].x; x.y = ALPHA * x.y + vs[i].y; x.z = ALPHA * x.z + vs[i].z; x.w = ALPHA * x.w + vs[i].w;
          *(float4*)(xb + (((unsigned)(m0 + wm_ * 64 + row)) * 1024u + (unsigned)(n0 + wn_ * 128 + ni * 32 + ch * 4)) * 4u) = x;
        }
      }
    }
    __syncthreads();
  }
}

DI GOp op_ffnup(const Ctx& p, int mt, int nt) {
  GOp o; o.W = ws_W(p) + W_UP + (size_t)(nt * 128) * 1024; o.X = ws_xb(p) + (size_t)(mt * 256) * 1024; o.ldw = 1024; o.ldx = 1024; o.K = 1024;
  o.wr1 = (unsigned)FF * 2048u; o.wr2 = 64u * 2048u; o.wr3 = (unsigned)(FF + 64) * 2048u;
  return o;
}
DI void ph_ffnup(const Ctx& p, int l, int mt, int nt, int mtn, int ntn, bool has_next, bool primed, GStage& g, char* smem) {
  const int c0 = nt * 128, m0 = mt * 256;
  f32x16 acc[4][2];
#pragma unroll
  for (int i = 0; i < 4; ++i)
#pragma unroll
    for (int j = 0; j < 2; ++j) acc[i][j] = zero16();
  gemm8<4, 2>(p, op_ffnup(p, mt, nt), op_ffnup(p, mt, nt), false, false, g, acc, smem);
  const int l_ = p.tid8 & 63, w_ = p.tid8 >> 6, r_ = l_ & 31, h_ = l_ >> 5, wn_ = w_ & 1, wm_ = w_ >> 1;
  u16* sl = (u16*)(smem + 73728 + w_ * 9216);
  u16* sh = (u16*)(smem + w_ * 9216);
#pragma unroll
  for (int ni = 0; ni < 2; ++ni)
#pragma unroll
    for (int mi = 0; mi < 2; ++mi)
#pragma unroll
      for (int gq = 0; gq < 4; ++gq) {
        uint2 o; o.x = pk2(acc[ni][mi][4 * gq + 0], acc[ni][mi][4 * gq + 1]); o.y = pk2(acc[ni][mi][4 * gq + 2], acc[ni][mi][4 * gq + 3]);
        *(uint2*)(sl + (mi * 32 + r_) * 72 + ni * 32 + 8 * gq + 4 * h_) = o;
      }
  __syncthreads();
  const float* cw = p.kp.in[27] + (size_t)l * 3 * FF;
  const float* cb = p.kp.in[28] + (size_t)l * FF;
  const u16* halo = (const u16*)(p.ws + OFF_HALO) + (size_t)(2 * mt) * FF;
  const bool seq_start = (m0 & (SEQ - 1)) == 0;
  const u16* prv = sl - 2 * 4608;
#pragma unroll
  for (int ni = 0; ni < 2; ++ni)
#pragma unroll
    for (int gq = 0; gq < 4; ++gq) {
      const int cl = ni * 32 + 8 * gq + 4 * h_;
      int cg = c0 + wn_ * 64 + cl;
      asm volatile("" : "+v"(cg));
      const float4 w0 = *(const float4*)(cw + cg), w1 = *(const float4*)(cw + FF + cg), w2 = *(const float4*)(cw + 2 * FF + cg);
      const float4 b4 = *(const float4*)(cb + cg);
#pragma unroll
      for (int mi = 0; mi < 2; ++mi) {
        const int tokl = mi * 32 + r_;
        uint2 um1, um2;
        if (mi == 1) {
          um1 = *(const uint2*)(sl + (tokl - 1) * 72 + cl);
          um2 = *(const uint2*)(sl + (tokl - 2) * 72 + cl);
        } else {
          const u16* p1 = (tokl >= 1) ? sl + (tokl - 1) * 72 : prv + 63 * 72;
          const u16* p2 = (tokl >= 2) ? sl + (tokl - 2) * 72 : prv + (62 + tokl) * 72;
          um1 = *(const uint2*)(p1 + cl);
          um2 = *(const uint2*)(p2 + cl);
          if (wm_ == 0) {
            if (tokl == 0) { um1 = make_uint2(0, 0); if (!seq_start) um1 = *(const uint2*)(halo + FF + cg); }
            if (tokl < 2) { um2 = make_uint2(0, 0); if (!seq_start) um2 = *(const uint2*)(halo + (size_t)tokl * FF + cg); }
          }
        }
        float c0v = b4.x + w0.x * bflo(um2.x) + w1.x * bflo(um1.x) + w2.x * acc[ni][mi][4 * gq + 0];
        float c1v = b4.y + w0.y * bfhi(um2.x) + w1.y * bfhi(um1.x) + w2.y * acc[ni][mi][4 * gq + 1];
        float c2v = b4.z + w0.z * bflo(um2.y) + w1.z * bflo(um1.y) + w2.z * acc[ni][mi][4 * gq + 2];
        float c3v = b4.w + w0.w * bfhi(um2.y) + w1.w * bfhi(um1.y) + w2.w * acc[ni][mi][4 * gq + 3];
        uint2 ho;
        ho.x = pk2(gelu_t(c0v) * acc[ni + 2][mi][4 * gq + 0], gelu_t(c1v) * acc[ni + 2][mi][4 * gq + 1]);
        ho.y = pk2(gelu_t(c2v) * acc[ni + 2][mi][4 * gq + 2], gelu_t(c3v) * acc[ni + 2][mi][4 * gq + 3]);
        *(uint2*)(sh + tokl * 72 + cl) = ho;
      }
    }
  char* H = (char*)ws_P(p);
#pragma unroll
  for (int i = 0; i < 8; ++i) {
    const int row = (l_ >> 3) + 8 * i, ch = l_ & 7;
    uint4 v = *(const uint4*)(sh + row * 72 + ch * 8);
    *(uint4*)(H + (((unsigned)(m0 + wm_ * 64 + row)) * (unsigned)FF + (unsigned)(c0 + wn_ * 64 + ch * 8)) * 2u) = v;
  }
}

DI void ph_halo(const Ctx& p, int wi) {
  const int l_ = p.tid8 & 63, r = l_ & 31, h = l_ >> 5;
  const int hg = wi & 7, cg = wi >> 3;
  const int hrow = hg * 32 + r;
  int tok = 256 * (hrow >> 1) - 2 + (hrow & 1);
  tok = tok < 0 ? 0 : tok;
  const u16* wrow = ws_W(p) + W_UP + (size_t)(cg * 32 + r) * 1024 + h * 8;
  const u16* xrow = ws_xb(p) + (size_t)tok * 1024 + h * 8;
  f32x16 acc = zero16();
#pragma unroll 8
  for (int ks = 0; ks < 64; ++ks) {
    bf16x8 a = *(const bf16x8*)(wrow + ks * 16);
    bf16x8 bq = *(const bf16x8*)(xrow + ks * 16);
    acc = MFMA32(a, bq, acc);
  }
  u16* halo = (u16*)(p.ws + OFF_HALO);
#pragma unroll
  for (int gq = 0; gq < 4; ++gq) {
    uint2 o; o.x = pk2(acc[4 * gq + 0], acc[4 * gq + 1]); o.y = pk2(acc[4 * gq + 2], acc[4 * gq + 3]);
    *(uint2*)(halo + (size_t)hrow * FF + cg * 32 + 8 * gq + 4 * h) = o;
  }
}

DI void unpack8(uint4 v, float (&f)[8]) {
  f[0] = bflo(v.x); f[1] = bfhi(v.x); f[2] = bflo(v.y); f[3] = bfhi(v.y);
  f[4] = bflo(v.z); f[5] = bfhi(v.z); f[6] = bflo(v.w); f[7] = bfhi(v.w);
}

DI void ph_ffnh(const Ctx& p, int l, int item) {
  int task = item * 256 + p.tid;
  int rb = task / 352, cgp = task - rb * 352;
  int c0 = cgp * 8;
  size_t row0 = (size_t)rb * 16;
  int tseq = (int)(row0 & (SEQ - 1));
  const float* cw = p.kp.in[27] + (size_t)l * 3 * FF + c0;
  const float* cb = p.kp.in[28] + (size_t)l * FF + c0;
  float w0[8], w1[8], w2[8], bb[8];
  *(float4*)&w0[0] = *(const float4*)(cw); *(float4*)&w0[4] = *(const float4*)(cw + 4);
  *(float4*)&w1[0] = *(const float4*)(cw + FF); *(float4*)&w1[4] = *(const float4*)(cw + FF + 4);
  *(float4*)&w2[0] = *(const float4*)(cw + 2 * FF); *(float4*)&w2[4] = *(const float4*)(cw + 2 * FF + 4);
  *(float4*)&bb[0] = *(const float4*)(cb); *(float4*)&bb[4] = *(const float4*)(cb + 4);
  u16* UV = ws_P(p);
  float um2[8], um1[8];
  if (tseq > 0) {
    unpack8(*(const uint4*)(UV + (row0 - 2) * 5632 + c0), um2);
    unpack8(*(const uint4*)(UV + (row0 - 1) * 5632 + c0), um1);
  } else {
#pragma unroll
    for (int j = 0; j < 8; ++j) { um2[j] = 0.f; um1[j] = 0.f; }
  }
  for (int i4 = 0; i4 < 16; i4 += 4) {
    uint4 ur[4], vr[4];
#pragma unroll
    for (int i = 0; i < 4; ++i) {
      ur[i] = *(const uint4*)(UV + (row0 + i4 + i) * 5632 + c0);
      vr[i] = *(const uint4*)(UV + (row0 + i4 + i) * 5632 + FF + c0);
    }
#pragma unroll
    for (int i = 0; i < 4; ++i) {
      float u[8], v[8];
      unpack8(ur[i], u); unpack8(vr[i], v);
      float hh[8];
#pragma unroll
      for (int j = 0; j < 8; ++j) {
        float cv = bb[j] + w0[j] * um2[j] + w1[j] * um1[j] + w2[j] * u[j];
        hh[j] = gelu_t(cv) * v[j];
        um2[j] = um1[j]; um1[j] = u[j];
      }
      uint4 o; o.x = pk2(hh[0], hh[1]); o.y = pk2(hh[2], hh[3]); o.z = pk2(hh[4], hh[5]); o.w = pk2(hh[6], hh[7]);
      *(uint4*)(UV + (row0 + i4 + i) * 5632 + FF + c0) = o;
    }
  }
}

DI void hgrn_lfk(float fl, float lb, float& lf, float& kk) {
  fl = fminf(fmaxf(fl, -30.f), 30.f);
  float e = __expf(-fl);
  float sig = frcp(1.f + e);
  float f = lb + (1.f - lb) * sig;
  lf = __logf(f);
  kk = (1.f - lb) * e * sig;
}
DI float hgrn_lb(const Ctx& p, int l, int ch) {
  if (l == 0) return 0.f;
  float z0 = p.kp.in[5][ch], z1 = p.kp.in[5][512 + ch];
  return frcp(1.f + __expf(z0 - z1));
}


struct TilePf { uint4 v[4]; };
DI void tile_fetch(const Ctx& p, TilePf& t, const u16* __restrict__ src, size_t ld, int rows, int first_valid = 0) {
#pragma unroll
  for (int i = 0; i < 4; ++i) {
    const int idx = p.tid + 256 * i, rr = idx >> 4, cc = idx & 15;
    t.v[i] = make_uint4(0, 0, 0, 0);
    if (rr < rows && rr >= first_valid) t.v[i] = *(const uint4*)(src + (long)rr * (long)ld + cc * 8);
  }
}
DI void tile_put(const Ctx& p, const TilePf& t, u16* sdst, int rows) {
#pragma unroll
  for (int i = 0; i < 4; ++i) {
    const int idx = p.tid + 256 * i, rr = idx >> 4, cc = idx & 15;
    if (rr < rows) *(uint4*)(sdst + rr * 136 + cc * 8) = t.v[i];
  }
}
DI void load_tile128(const Ctx& p, u16* sdst, const u16* __restrict__ src, size_t ld, int rows, int first_valid = 0) {
  TilePf t;
  tile_fetch(p, t, src, ld, rows, first_valid);
  tile_put(p, t, sdst, rows);
}
DI void store_tile128(const Ctx& p, const u16* ssrc, u16* __restrict__ dst, size_t ld, int rows) {
  for (int idx = p.tid; idx < rows * 16; idx += 256) {
    int rr = idx >> 4, cc = idx & 15;
    *(uint4*)(dst + (size_t)rr * ld + cc * 8) = *(const uint4*)(ssrc + rr * 136 + cc * 8);
  }
}

DI void hgrnA_fetch(const Ctx& p, int it, TilePf& pf0, TilePf& pf1) {
  const int c = it & 127, hh = (it >> 7) & 3, b = it >> 9;
  const size_t row0 = (size_t)b * SEQ + c * 64;
  const u16* P = ws_P(p);
  tile_fetch(p, pf0, P + row0 * PW + C_HF + hh * 128, PW, 64);
  tile_fetch(p, pf1, P + row0 * PW + C_HI + hh * 128, PW, 64);
}
DI void hgrn_A(const Ctx& p, int l, int it, char* smem, TilePf& pf0, TilePf& pf1, bool primed, int it_next) {
  u16* sKT = (u16*)smem;
  u16* sIT = sKT + 128 * 72;
  u16* sF = sIT + 128 * 72;
  u16* sI = sF + 64 * 136;
  float* psum = (float*)(sI + 64 * 136);
  const int tid = p.tid, k = tid & 127, half = tid >> 7;
  const int c = it & 127, hh = (it >> 7) & 3, b = it >> 9;
  const size_t row0 = (size_t)b * SEQ + c * 64;
  const u16* P = ws_P(p);
  const float lb = hgrn_lb(p, l, hh * 128 + k);
  __syncthreads();
  if (!primed) hgrnA_fetch(p, it, pf0, pf1);
  tile_put(p, pf0, sF, 64);
  tile_put(p, pf1, sI, 64);
  __syncthreads();
  if (it_next >= 0) hgrnA_fetch(p, it_next, pf0, pf1);
  const u16* fp = sF + (half * 32) * 136 + k;
  const u16* ip = sI + (half * 32) * 136 + k;
  float s = 0.f;
  float lfa[32], kka[32];
#pragma unroll
  for (int t = 0; t < 32; ++t) { hgrn_lfk(bf2f(fp[t * 136]), lb, lfa[t], kka[t]); s += lfa[t]; }
  psum[half * 128 + k] = s;
  __syncthreads();
  const float base = half ? psum[k] : 0.f;
  const float total = psum[k] + psum[128 + k];
  float bb = base;
#pragma unroll
  for (int t8 = 0; t8 < 4; ++t8) {
    float kv[8]; u16 iv[8];
#pragma unroll
    for (int j = 0; j < 8; ++j) {
      int t = t8 * 8 + j;
      bb += lfa[t];
      kv[j] = kka[t] * __expf(total - bb);
      iv[j] = ip[t * 136];
    }
    uint4 ko; ko.x = pk2(kv[0], kv[1]); ko.y = pk2(kv[2], kv[3]); ko.z = pk2(kv[4], kv[5]); ko.w = pk2(kv[6], kv[7]);
    *(uint4*)(sKT + k * 72 + half * 32 + t8 * 8) = ko;
    uint4 io; io.x = iv[0] | ((u32)iv[1] << 16); io.y = iv[2] | ((u32)iv[3] << 16); io.z = iv[4] | ((u32)iv[5] << 16); io.w = iv[6] | ((u32)iv[7] << 16);
    *(uint4*)(sIT + k * 72 + half * 32 + t8 * 8) = io;
  }
  if (half == 0) ((float*)(p.ws + OFF_DEC))[(size_t)it * 128 + k] = __expf(total);
  __syncthreads();
  const int l_ = tid & 63, w = tid >> 6, kn = w & 1, vm = w >> 1, r = l_ & 31, h = l_ >> 5;
  f32x16 acc[2][2];
#pragma unroll
  for (int i = 0; i < 2; ++i)
#pragma unroll
    for (int j = 0; j < 2; ++j) acc[i][j] = zero16();
#pragma unroll
  for (int ks = 0; ks < 4; ++ks) {
    bf16x8 a[2], bq[2];
#pragma unroll
    for (int ni = 0; ni < 2; ++ni) a[ni] = *(const bf16x8*)(sKT + (kn * 64 + ni * 32 + r) * 72 + ks * 16 + h * 8);
#pragma unroll
    for (int mi = 0; mi < 2; ++mi) bq[mi] = *(const bf16x8*)(sIT + (vm * 64 + mi * 32 + r) * 72 + ks * 16 + h * 8);
#pragma unroll
    for (int ni = 0; ni < 2; ++ni)
#pragma unroll
      for (int mi = 0; mi < 2; ++mi) acc[ni][mi] = MFMA32(a[ni], bq[mi], acc[ni][mi]);
  }
  u16* HS = ws_HS(p) + (size_t)it * 16384;
  __syncthreads();
  {
    u16* sl = (u16*)smem + w * 4608;
#pragma unroll
    for (int ni = 0; ni < 2; ++ni)
#pragma unroll
      for (int mi = 0; mi < 2; ++mi)
#pragma unroll
        for (int gq = 0; gq < 4; ++gq) {
          uint2 o; o.x = pk2(acc[ni][mi][4 * gq], acc[ni][mi][4 * gq + 1]); o.y = pk2(acc[ni][mi][4 * gq + 2], acc[ni][mi][4 * gq + 3]);
          *(uint2*)(sl + (mi * 32 + r) * 72 + ni * 32 + 8 * gq + 4 * h) = o;
        }
#pragma unroll
    for (int i = 0; i < 8; ++i) {
      const int row = (l_ >> 3) + 8 * i, ch = l_ & 7;
      uint4 vv = *(const uint4*)(sl + row * 72 + ch * 8);
      *(uint4*)(HS + (vm * 64 + row) * 128 + kn * 64 + ch * 8) = vv;
    }
  }
}

DI void hgrn_B(const Ctx& p, int item) {
  int e2 = item * 256 + p.tid;
  int bh = e2 >> 13;
  int vk = (e2 & 8191) * 2;
  int k = vk & 127;
  u32* hs = (u32*)ws_HS(p);
  const float* dec = (const float*)(p.ws + OFF_DEC);
  float s0 = 0.f, s1 = 0.f;
  for (int c8 = 0; c8 < 128; c8 += 8) {
    u32 v[8]; float2 d[8];
#pragma unroll
    for (int i = 0; i < 8; ++i) {
      size_t idx = (((size_t)(bh * 128 + c8 + i)) * 16384 + vk) >> 1;
      v[i] = hs[idx];
      d[i] = *(const float2*)(dec + (size_t)(bh * 128 + c8 + i) * 128 + k);
    }
#pragma unroll
    for (int i = 0; i < 8; ++i) {
      size_t idx = (((size_t)(bh * 128 + c8 + i)) * 16384 + vk) >> 1;
      hs[idx] = pk2(s0, s1);
      s0 = d[i].x * s0 + bflo(v[i]);
      s1 = d[i].y * s1 + bfhi(v[i]);
    }
  }
}

DI void hgrnC_fetch(const Ctx& p, int it, TilePf& pf0, TilePf& pf1, TilePf& pf2) {
  const int c = it & 127, hh = (it >> 7) & 3, b = it >> 9;
  const size_t row0 = (size_t)b * SEQ + c * 64;
  const u16* P = ws_P(p);
  tile_fetch(p, pf0, P + row0 * PW + C_HF + hh * 128, PW, 64);
  tile_fetch(p, pf1, P + row0 * PW + C_HQ + hh * 128, PW, 64);
  tile_fetch(p, pf2, P + row0 * PW + C_HI + hh * 128, PW, 64);
}
DI void hgrn_C(const Ctx& p, int l, int it, char* smem, TilePf& pf0, TilePf& pf1, TilePf& pf2, bool primed, int it_next) {
  u16* sQ = (u16*)smem;
  u16* sK = sQ + 64 * 136;
  u16* sIT = sK + 64 * 136;
  u16* sI = sIT + 128 * 72;
  float* psum = (float*)(sI + 64 * 136);
  float* red = psum + 256;
  const int tid = p.tid, k = tid & 127, half = tid >> 7;
  const int c = it & 127, hh = (it >> 7) & 3, b = it >> 9;
  const size_t row0 = (size_t)b * SEQ + c * 64;
  u16* P = ws_P(p);
  const float lb = hgrn_lb(p, l, hh * 128 + k);
  __syncthreads();
  if (!primed) hgrnC_fetch(p, it, pf0, pf1, pf2);
  tile_put(p, pf0, sK, 64);
  tile_put(p, pf1, sQ, 64);
  tile_put(p, pf2, sI, 64);
  __syncthreads();
  if (it_next >= 0) hgrnC_fetch(p, it_next, pf0, pf1, pf2);
  u16* fp = sK + (half * 32) * 136 + k;
  u16* qp = sQ + (half * 32) * 136 + k;
  const u16* ip = sI + (half * 32) * 136 + k;
  float s = 0.f;
  float lfa[32], kka[32];
#pragma unroll
  for (int t = 0; t < 32; ++t) { hgrn_lfk(bf2f(fp[t * 136]), lb, lfa[t], kka[t]); s += lfa[t]; }
  psum[half * 128 + k] = s;
  __syncthreads();
  float bb = half ? psum[k] : 0.f;
#pragma unroll
  for (int t8 = 0; t8 < 4; ++t8) {
    u16 iv[8];
#pragma unroll
    for (int j = 0; j < 8; ++j) {
      int t = t8 * 8 + j;
      bb += lfa[t];
      float q = bf2f(qp[t * 136]);
      float eb = __expf(bb);
      qp[t * 136] = f2bf(q * eb);
      fp[t * 136] = f2bf(kka[t] * __expf(-bb));
      iv[j] = ip[t * 136];
    }
    uint4 io; io.x = iv[0] | ((u32)iv[1] << 16); io.y = iv[2] | ((u32)iv[3] << 16); io.z = iv[4] | ((u32)iv[5] << 16); io.w = iv[6] | ((u32)iv[7] << 16);
    *(uint4*)(sIT + k * 72 + half * 32 + t8 * 8) = io;
  }
  __syncthreads();
  load_tile128(p, sI, P + row0 * PW + C_HG + hh * 128, PW, 64);
  const int l_ = tid & 63, w = tid >> 6, tt = w & 1, vh = w >> 1, r = l_ & 31, h = l_ >> 5;
  f32x16 att0 = zero16(), att1 = zero16();
#pragma unroll
  for (int ks = 0; ks < 8; ++ks) {
    bf16x8 bq = *(const bf16x8*)(sQ + (tt * 32 + r) * 136 + ks * 16 + h * 8);
    bf16x8 a0 = *(const bf16x8*)(sK + (r) * 136 + ks * 16 + h * 8);
    att0 = MFMA32(a0, bq, att0);
    if (tt) {
      bf16x8 a1 = *(const bf16x8*)(sK + (32 + r) * 136 + ks * 16 + h * 8);
      att1 = MFMA32(a1, bq, att1);
    }
  }
#pragma unroll
  for (int reg = 0; reg < 16; ++reg) {
    bool keep = crow(reg, h) <= r;
    if (tt) att1[reg] = keep ? att1[reg] : 0.f; else att0[reg] = keep ? att0[reg] : 0.f;
  }
  f32x16 o[2]; o[0] = zero16(); o[1] = zero16();
  {
    bf16x8 pf0 = pack8<0>(att0), pf1 = pack8<1>(att0);
#pragma unroll
    for (int vt = 0; vt < 2; ++vt) {
      const u16* base = sIT + (vh * 64 + vt * 32 + r) * 72 + 4 * h;
      o[vt] = MFMA32(cat4(*(const bf16x4*)(base), *(const bf16x4*)(base + 8)), pf0, o[vt]);
      o[vt] = MFMA32(cat4(*(const bf16x4*)(base + 16), *(const bf16x4*)(base + 24)), pf1, o[vt]);
    }
  }
  if (tt) {
    bf16x8 pf0 = pack8<0>(att1), pf1 = pack8<1>(att1);
#pragma unroll
    for (int vt = 0; vt < 2; ++vt) {
      const u16* base = sIT + (vh * 64 + vt * 32 + r) * 72 + 32 + 4 * h;
      o[vt] = MFMA32(cat4(*(const bf16x4*)(base), *(const bf16x4*)(base + 8)), pf0, o[vt]);
      o[vt] = MFMA32(cat4(*(const bf16x4*)(base + 16), *(const bf16x4*)(base + 24)), pf1, o[vt]);
    }
  }
  const u16* HS = ws_HS(p) + (size_t)it * 16384;
#pragma unroll
  for (int ks = 0; ks < 8; ++ks) {
    bf16x8 bq = *(const bf16x8*)(sQ + (tt * 32 + r) * 136 + ks * 16 + h * 8);
#pragma unroll
    for (int vt = 0; vt < 2; ++vt) {
      bf16x8 a = *(const bf16x8*)(HS + (vh * 64 + vt * 32 + r) * 128 + ks * 16 + h * 8);
      o[vt] = MFMA32(a, bq, o[vt]);
    }
  }
  float ss = 0.f;
#pragma unroll
  for (int vt = 0; vt < 2; ++vt)
#pragma unroll
    for (int reg = 0; reg < 16; ++reg) ss += o[vt][reg] * o[vt][reg];
  ss += __shfl_xor(ss, 32);
  if (h == 0) red[vh * 64 + tt * 32 + r] = ss;
  __syncthreads();
  const float tot = red[tt * 32 + r] + red[64 + tt * 32 + r];
  const float rinv = rsqrtf(tot * (1.f / 128.f) + 1e-6f);
  const float* ng = p.kp.in[6] + (size_t)l * 512 + hh * 128;
#pragma unroll
  for (int vt = 0; vt < 2; ++vt)
#pragma unroll
    for (int gq = 0; gq < 4; ++gq) {
      int v = vh * 64 + vt * 32 + 8 * gq + 4 * h;
      uint2 gv = *(const uint2*)(sI + (tt * 32 + r) * 136 + v);
      float4 n4 = *(const float4*)(ng + v);
      float g0 = bflo(gv.x), g1 = bfhi(gv.x), g2 = bflo(gv.y), g3 = bfhi(gv.y);
      float y0 = o[vt][4 * gq + 0] * rinv * n4.x * (g0 * sigmoidf_(g0));
      float y1 = o[vt][4 * gq + 1] * rinv * n4.y * (g1 * sigmoidf_(g1));
      float y2 = o[vt][4 * gq + 2] * rinv * n4.z * (g2 * sigmoidf_(g2));
      float y3 = o[vt][4 * gq + 3] * rinv * n4.w * (g3 * sigmoidf_(g3));
      uint2 ov; ov.x = pk2(y0, y1); ov.y = pk2(y2, y3);
      *(uint2*)(sQ + (tt * 32 + r) * 136 + v) = ov;
    }
  __syncthreads();
  store_tile128(p, sQ, P + row0 * PW + C_HQ + hh * 128, PW, 64);
}

template <bool FINAL>
DI void lru_fetch(const Ctx& p, int it, TilePf& pf0, TilePf& pf1) {
  const int g = it & 3, tile = (it >> 2) & 255, b = it >> 10;
  const int t0 = tile * 32;
  const u16* P = ws_P(p);
  tile_fetch(p, pf0, P + ((long)b * SEQ + t0 - 3) * (long)PW + C_LX + g * 128, PW, 35, (t0 == 0) ? 3 : 0);
  if (FINAL) tile_fetch(p, pf1, P + ((size_t)b * SEQ + t0) * PW + C_LY + g * 128, PW, 32);
}
template <bool FINAL>
DI void lru_item(const Ctx& p, int l, int it, char* smem, TilePf& pf0, TilePf& pf1, bool primed, int it_next) {
  u16* sXc = (u16*)smem;
  float* sA = (float*)(sXc + 32 * 136);
  float* sU = sA + 32 * 128;
  float* sC = sU + 32 * 128;
  u16* sXr = (u16*)(sC + 512);
  u16* sY = sXr + 35 * 136;
  const int tid = p.tid, c = tid & 127, half = tid >> 7;
  const int g = it & 3, tile = (it >> 2) & 255, b = it >> 10;
  const int t0 = tile * 32, ch = g * 128 + c;
  u16* P = ws_P(p);
  const float* cw = p.kp.in[13] + (size_t)l * 4 * 512;
  const float w0 = cw[ch], w1 = cw[512 + ch], w2 = cw[1024 + ch], w3 = cw[1536 + ch], cb = p.kp.in[14][l * 512 + ch];
  const int ts = t0 + half * 16;
  __syncthreads();
  if (!primed) lru_fetch<FINAL>(p, it, pf0, pf1);
  tile_put(p, pf0, sXr, 35);
  if (FINAL) tile_put(p, pf1, sY, 32);
  bf16x8 waf[8], wxf[8];
  {
    const int l0_ = tid & 63, w0_ = tid >> 6;
    const u16* wa_ = ws_W(p) + W_LA + g * 16384 + (w0_ * 32 + (l0_ & 31)) * 128 + (l0_ >> 5) * 8;
    const u16* wx_ = ws_W(p) + W_LX + g * 16384 + (w0_ * 32 + (l0_ & 31)) * 128 + (l0_ >> 5) * 8;
#pragma unroll
    for (int ks = 0; ks < 8; ++ks) { waf[ks] = *(const bf16x8*)(wa_ + ks * 16); wxf[ks] = *(const bf16x8*)(wx_ + ks * 16); }
  }
  __syncthreads();
  if (it_next >= 0) lru_fetch<FINAL>(p, it_next, pf0, pf1);
  {
    const u16* xr = sXr + (half * 16) * 136 + c;
    float x0 = bf2f(xr[0]), x1 = bf2f(xr[136]), x2 = bf2f(xr[2 * 136]);
#pragma unroll 4
    for (int i = 0; i < 16; ++i) {
      float x3 = bf2f(xr[(i + 3) * 136]);
      float xc = cb + w0 * x0 + w1 * x1 + w2 * x2 + w3 * x3;
      sXc[(half * 16 + i) * 136 + c] = f2bf(xc);
      x0 = x1; x1 = x2; x2 = x3;
    }
  }
  __syncthreads();
  const int l_ = tid & 63, w = tid >> 6, r = l_ & 31, h = l_ >> 5;
  f32x16 ar = zero16(), ai = zero16();
#pragma unroll
  for (int ks = 0; ks < 8; ++ks) {
    bf16x8 bx = *(const bf16x8*)(sXc + r * 136 + ks * 16 + h * 8);
    ar = MFMA32(waf[ks], bx, ar);
    ai = MFMA32(wxf[ks], bx, ai);
  }
  const float* bap = p.kp.in[16] + (size_t)l * 512 + g * 128;
  const float* bxp = p.kp.in[18] + (size_t)l * 512 + g * 128;
  const float* lmp = p.kp.in[19] + (size_t)l * 512 + g * 128;
#pragma unroll
  for (int gq = 0; gq < 4; ++gq) {
    int jb = w * 32 + 8 * gq + 4 * h;
    float4 ba4 = *(const float4*)(bap + jb), bx4 = *(const float4*)(bxp + jb), lm4 = *(const float4*)(lmp + jb);
    float bav[4] = {ba4.x, ba4.y, ba4.z, ba4.w}, bxv[4] = {bx4.x, bx4.y, bx4.z, bx4.w}, lmv[4] = {lm4.x, lm4.y, lm4.z, lm4.w};
    float av[4], uv[4];
#pragma unroll
    for (int jj = 0; jj < 4; ++jj) {
      float rr = sigmoidf_(ar[4 * gq + jj] + bav[jj]);
      float ii = sigmoidf_(ai[4 * gq + jj] + bxv[jj]);
      float ex = __expf(-lmv[jj]);
      float sp = (ex < 0.03f) ? ex * (1.f - ex * (0.5f - ex * (0.33333334f - 0.25f * ex))) : __logf(1.f + ex);
      float la = -8.f * rr * sp;
      float aa = __expf(la);
      av[jj] = aa;
      float x2 = 2.f * la;
      float om = (x2 > -0.03f) ? -x2 * (1.f + x2 * (0.5f + x2 * (0.16666667f + 0.041666668f * x2))) : 1.f - aa * aa;
      float xcv = bf2f(sXc[r * 136 + jb + jj]);
      uv[jj] = __builtin_amdgcn_sqrtf(fmaxf(om, 0.f)) * ii * xcv;
    }
    *(float4*)(sA + r * 128 + jb) = make_float4(av[0], av[1], av[2], av[3]);
    *(float4*)(sU + r * 128 + jb) = make_float4(uv[0], uv[1], uv[2], uv[3]);
  }
  __syncthreads();
  float A = 1.f, H = 0.f;
#pragma unroll 4
  for (int i = 0; i < 16; ++i) {
    float a = sA[(half * 16 + i) * 128 + c], u = sU[(half * 16 + i) * 128 + c];
    H = a * H + u; A *= a;
  }
  sC[(half * 128 + c) * 2] = A; sC[(half * 128 + c) * 2 + 1] = H;
  __syncthreads();
  const float A0 = sC[c * 2], H0 = sC[c * 2 + 1], A1 = sC[(128 + c) * 2], H1 = sC[(128 + c) * 2 + 1];
  const size_t ci = ((size_t)(b * 256 + tile)) * 512 + ch;
  float* carA = (float*)(p.ws + OFF_CARA);
  float* carH = (float*)(p.ws + OFF_CARH);
  if (!FINAL) {
    if (half == 0) { carA[ci] = A0 * A1; carH[ci] = A1 * H0 + H1; }
  } else {
    float hin = ((const float*)(p.ws + OFF_CARI))[ci];
    float hs = half ? (A0 * hin + H0) : hin;
#pragma unroll 4
    for (int i = 0; i < 16; ++i) {
      float a = sA[(half * 16 + i) * 128 + c], u = sU[(half * 16 + i) * 128 + c];
      hs = a * hs + u;
      float y = bf2f(sY[(half * 16 + i) * 136 + c]);
      sY[(half * 16 + i) * 136 + c] = f2bf(hs * gelu_t(y));
    }
    __syncthreads();
    store_tile128(p, sY, P + ((size_t)b * SEQ + t0) * PW + C_LY + g * 128, PW, 32);
  }
}

DI void lru_B(const Ctx& p, int item) {
  int chain = item * 256 + p.tid;
  int b = chain >> 9, ch = chain & 511;
  const float* __restrict__ carA = (const float*)(p.ws + OFF_CARA);
  const float* __restrict__ carH = (const float*)(p.ws + OFF_CARH);
  float* __restrict__ hin = (float*)(p.ws + OFF_CARI);
  float s = 0.f;
  for (int t32 = 0; t32 < 256; t32 += 32) {
    float A[32], H[32];
#pragma unroll
    for (int i = 0; i < 32; ++i) {
      size_t ci = ((size_t)(b * 256 + t32 + i)) * 512 + ch;
      A[i] = carA[ci]; H[i] = carH[ci];
    }
#pragma unroll
    for (int i = 0; i < 32; ++i) {
      size_t ci = ((size_t)(b * 256 + t32 + i)) * 512 + ch;
      hin[ci] = s;
      s = A[i] * s + H[i];
    }
  }
}

DI void nsa_compress(const Ctx& p, int l, int it, char* smem) {
  u16* sT = (u16*)smem;
  float* sPart = (float*)smem;
  float* sH = (float*)(smem + 32768);
  const int tid = p.tid, l_ = tid & 63, w = tid >> 6, r = l_ & 31, h = l_ >> 5;
  const int kv = it & 1, grp = (it >> 1) & 31, g = (it >> 6) & 1, b = it >> 7;
  const float* w2 = p.kp.in[kv ? 12 : 9] + (size_t)l * 64 * 64;
  const u16* w1f = (const u16*)(p.ws + OFF_W1F) + (size_t)kv * 131072;
  const float* pev = (const float*)(p.ws + OFF_PEV) + kv * 64;
  const int n0 = grp * 16, col = (kv ? C_VC : C_KC) + g * 64;
  const u16* P = ws_P(p);
  __syncthreads();
#pragma unroll
  for (int bt = 0; bt < 2; ++bt) {
    uint4 v[5];
#pragma unroll
    for (int i = 0; i < 5; ++i) {
      const int idx = tid + 256 * (bt * 5 + i);
      const int rr = idx >> 3, c = idx & 7;
      const int t = 16 * n0 + rr;
      v[i] = make_uint4(0, 0, 0, 0);
      if (idx < 272 * 8 && t < SEQ) v[i] = *(const uint4*)(P + ((size_t)b * SEQ + t) * PW + col + c * 8);
    }
#pragma unroll
    for (int i = 0; i < 5; ++i) {
      const int idx = tid + 256 * (bt * 5 + i);
      const int rr = idx >> 3, c = idx & 7;
      if (idx < 272 * 8) *(uint4*)(sT + rr * 64 + ((c ^ ((rr >> 4) & 7)) * 8)) = v[i];
    }
  }
  __syncthreads();
  f32x16 acc[2]; acc[0] = zero16(); acc[1] = zero16();
#pragma unroll 8
  for (int si = 0; si < 32; ++si) {
    const int s_ = w * 32 + si;
    const int p_ = s_ >> 2;
    const int row = 16 * r + p_;
    const int c = (s_ & 3) * 2 + h;
    bf16x8 bx = *(const bf16x8*)(sT + row * 64 + ((c ^ ((row >> 4) & 7)) * 8));
    bf16x8 a0 = *(const bf16x8*)(w1f + ((size_t)(0 * 128 + s_) * 64 + l_) * 8);
    bf16x8 a1 = *(const bf16x8*)(w1f + ((size_t)(1 * 128 + s_) * 64 + l_) * 8);
    acc[0] = MFMA32(a0, bx, acc[0]);
    acc[1] = MFMA32(a1, bx, acc[1]);
  }
  __syncthreads();
#pragma unroll
  for (int jt = 0; jt < 2; ++jt)
#pragma unroll
    for (int gq = 0; gq < 4; ++gq)
      *(float4*)(sPart + (w * 32 + r) * 64 + jt * 32 + 8 * gq + 4 * h) =
          make_float4(acc[jt][4 * gq + 0], acc[jt][4 * gq + 1], acc[jt][4 * gq + 2], acc[jt][4 * gq + 3]);
  __syncthreads();
  {
    const int nb = tid >> 3, jq = (tid & 7) * 8;
    float hv[8];
#pragma unroll
    for (int e = 0; e < 8; ++e)
      hv[e] = gelu_t(sPart[(0 * 32 + nb) * 64 + jq + e] + sPart[(1 * 32 + nb) * 64 + jq + e] + sPart[(2 * 32 + nb) * 64 + jq + e] +
                     sPart[(3 * 32 + nb) * 64 + jq + e] + pev[jq + e]);
    __syncthreads();
#pragma unroll
    for (int e = 0; e < 8; ++e) sH[nb * 64 + jq + e] = hv[e];
  }
  __syncthreads();
  {
    const int nb = tid >> 3, dq = (tid & 7) * 8;
    float o[8];
#pragma unroll
    for (int e = 0; e < 8; ++e) o[e] = 0.f;
#pragma unroll 4
    for (int jj = 0; jj < 64; ++jj) {
      const float hvj = sH[nb * 64 + jj];
      const float4 wa = *(const float4*)(w2 + jj * 64 + dq), wb = *(const float4*)(w2 + jj * 64 + dq + 4);
      o[0] += hvj * wa.x; o[1] += hvj * wa.y; o[2] += hvj * wa.z; o[3] += hvj * wa.w;
      o[4] += hvj * wb.x; o[5] += hvj * wb.y; o[6] += hvj * wb.z; o[7] += hvj * wb.w;
    }
    const int n = n0 + nb;
    if (nb < 16) {
    if (n >= 511) {
#pragma unroll
      for (int e = 0; e < 8; ++e) o[e] = 0.f;
    }
    if (kv == 0) {
      uint4 ov; ov.x = pk2(o[0], o[1]); ov.y = pk2(o[2], o[3]); ov.z = pk2(o[4], o[5]); ov.w = pk2(o[6], o[7]);
      *(uint4*)((u16*)(p.ws + OFF_KCG) + ((size_t)(b * 2 + g) * 512 + n) * 64 + dq) = ov;
    } else {
      u16* vcT = (u16*)(p.ws + OFF_VCT) + (size_t)(b * 2 + g) * 64 * 512;
#pragma unroll
      for (int e = 0; e < 8; ++e) vcT[(size_t)(dq + e) * 512 + n] = f2bf(o[e]);
    }
    }
  }
}

DI void nsa_vtrans(const Ctx& p, int it, char* smem) {
  u16* sT = (u16*)smem;
  const int tid = p.tid;
  const int which = it & 1, tb = it >> 1;
  const int b = tb >> 7, tblk = tb & 127;
  const int col = which ? C_VW : C_VS;
  u16* dst = (u16*)(p.ws + (which ? OFF_VWT : OFF_VST));
  const u16* P = ws_P(p);
  const size_t row0 = (size_t)b * SEQ + tblk * 64;
  __syncthreads();
#pragma unroll
  for (int i = 0; i < 4; ++i) {
    int idx = tid + 256 * i; int rr = idx >> 4, cc = idx & 15;
    uint4 v = *(const uint4*)(P + (row0 + rr) * PW + col + cc * 8);
    u32* d = (u32*)(sT + rr * 130 + cc * 8);
    d[0] = v.x; d[1] = v.y; d[2] = v.z; d[3] = v.w;
  }
  __syncthreads();
  const int gd = tid >> 1, half = tid & 1;
#pragma unroll
  for (int q = 0; q < 4; ++q) {
    u16 e[8];
#pragma unroll
    for (int j = 0; j < 8; ++j) e[j] = sT[(half * 32 + q * 8 + j) * 130 + gd];
    uint4 o; o.x = e[0] | ((u32)e[1] << 16); o.y = e[2] | ((u32)e[3] << 16); o.z = e[4] | ((u32)e[5] << 16); o.w = e[6] | ((u32)e[7] << 16);
    *(uint4*)(dst + ((size_t)(b * 128 + gd)) * SEQ + tblk * 64 + half * 32 + q * 8) = o;
  }
}

struct FlashState { f32x16 o[2]; float m, l; };
DI void flash_init(FlashState& s) { s.o[0] = zero16(); s.o[1] = zero16(); s.m = -INFINITY; s.l = 0.f; }

DI void nsa_load_tile(const Ctx& p, u16* sdst, const u16* __restrict__ src, size_t ld, int rows) {
  const int tid = p.tid8;
  for (int rr = tid >> 3; rr < rows; rr += 64) {
    uint4 v = *(const uint4*)(src + (size_t)rr * ld + (tid & 7) * 8);
    *(uint4*)(sdst + rr * 72 + (tid & 7) * 8) = v;
  }
}

template <bool MASKED, int PS>
DI void flash_sub2(FlashState& st, const u16* sQrow, const u16* sK, const u16* sVT, int sub, float slope2,
                   bool tokflag, int dist0, int maxdist, int r, int h) {
  const int d0h = dist0 - PS * 4 * h;
  const float base = -slope2 * (float)d0h;
  const float sps = slope2 * (float)PS;
  f32x16 s = zero16();
#pragma unroll
  for (int ks = 0; ks < 4; ++ks) {
    bf16x8 a = *(const bf16x8*)(sK + (sub * 32 + r) * 72 + ks * 16 + h * 8);
    bf16x8 qv = *(const bf16x8*)(sQrow + ks * 16);
    s = MFMA32(a, qv, s);
  }
  float mx = -INFINITY;
#pragma unroll
  for (int reg = 0; reg < 16; ++reg) {
    const int creg = (reg & 3) + 8 * (reg >> 2);
    float x = fmaf(s[reg], 1.4426950408889634f, fmaf(sps, (float)creg, base));
    if (MASKED) {
      int dist = d0h - PS * creg;
      x = (dist >= 0 && dist < maxdist) ? x : -INFINITY;
    }
    s[reg] = x;
    mx = fmaxf(mx, x);
  }
  mx = fmaxf(mx, __shfl_xor(mx, 32));
  mx = tokflag ? mx : -INFINITY;
  const float m_new = fmaxf(st.m, mx);
  const float m_use = (m_new == -INFINITY) ? 0.f : m_new;
  const float alpha = __builtin_amdgcn_exp2f(st.m - m_use);
  const float ml = tokflag ? m_use : INFINITY;
  float rs = 0.f;
#pragma unroll
  for (int reg = 0; reg < 16; ++reg) { float pv = __builtin_amdgcn_exp2f(s[reg] - ml); s[reg] = pv; rs += pv; }
  rs += __shfl_xor(rs, 32);
  st.l = st.l * alpha + rs;
  st.m = m_new;
  if (__any(alpha != 1.f)) {
#pragma unroll
    for (int dt = 0; dt < 2; ++dt)
#pragma unroll
      for (int reg = 0; reg < 16; ++reg) st.o[dt][reg] *= alpha;
  }
  bf16x8 pf0 = pack8<0>(s), pf1 = pack8<1>(s);
#pragma unroll
  for (int dt = 0; dt < 2; ++dt) {
    const u16* base_v = sVT + (dt * 32 + r) * 72 + sub * 32 + 4 * h;
    st.o[dt] = MFMA32(cat4(*(const bf16x4*)(base_v), *(const bf16x4*)(base_v + 8)), pf0, st.o[dt]);
    st.o[dt] = MFMA32(cat4(*(const bf16x4*)(base_v + 16), *(const bf16x4*)(base_v + 24)), pf1, st.o[dt]);
  }
}

template <int PS>
DI void flash_full(FlashState& st, const u16* sQrow, const u16* sK, const u16* sVT, float slope2,
                   bool tokflag, int dist0, int r, int h) {
  const int d0h = dist0 - PS * 4 * h;
  const float base = -slope2 * (float)d0h;
  const float sps = slope2 * (float)PS;
  f32x16 s0 = zero16(), s1 = zero16();
#pragma unroll
  for (int ks = 0; ks < 4; ++ks) {
    bf16x8 qv = *(const bf16x8*)(sQrow + ks * 16);
    bf16x8 a0 = *(const bf16x8*)(sK + r * 72 + ks * 16 + h * 8);
    bf16x8 a1 = *(const bf16x8*)(sK + (32 + r) * 72 + ks * 16 + h * 8);
    s0 = MFMA32(a0, qv, s0);
    s1 = MFMA32(a1, qv, s1);
  }
  float mx = -INFINITY;
#pragma unroll
  for (int reg = 0; reg < 16; ++reg) {
    const int creg = (reg & 3) + 8 * (reg >> 2);
    float x0 = fmaf(s0[reg], 1.4426950408889634f, fmaf(sps, (float)creg, base));
    float x1 = fmaf(s1[reg], 1.4426950408889634f, fmaf(sps, (float)(creg + 32), base));
    s0[reg] = x0; s1[reg] = x1;
    mx = fmaxf(mx, fmaxf(x0, x1));
  }
  mx = fmaxf(mx, __shfl_xor(mx, 32));
  mx = tokflag ? mx : -INFINITY;
  const float m_new = fmaxf(st.m, mx);
  const float m_use = (m_new == -INFINITY) ? 0.f : m_new;
  const float alpha = __builtin_amdgcn_exp2f(st.m - m_use);
  const float ml = tokflag ? m_use : INFINITY;
  float rs = 0.f;
#pragma unroll
  for (int reg = 0; reg < 16; ++reg) {
    float p0 = __builtin_amdgcn_exp2f(s0[reg] - ml), p1 = __builtin_amdgcn_exp2f(s1[reg] - ml);
    s0[reg] = p0; s1[reg] = p1; rs += p0 + p1;
  }
  rs += __shfl_xor(rs, 32);
  st.l = st.l * alpha + rs;
  st.m = m_new;
  if (__any(alpha != 1.f)) {
#pragma unroll
    for (int dt = 0; dt < 2; ++dt)
#pragma unroll
      for (int reg = 0; reg < 16; ++reg) st.o[dt][reg] *= alpha;
  }
  bf16x8 pf0 = pack8<0>(s0), pf1 = pack8<1>(s0), pf2 = pack8<0>(s1), pf3 = pack8<1>(s1);
#pragma unroll
  for (int dt = 0; dt < 2; ++dt) {
    const u16* bv = sVT + (dt * 32 + r) * 72 + 4 * h;
    st.o[dt] = MFMA32(cat4(*(const bf16x4*)(bv), *(const bf16x4*)(bv + 8)), pf0, st.o[dt]);
    st.o[dt] = MFMA32(cat4(*(const bf16x4*)(bv + 16), *(const bf16x4*)(bv + 24)), pf1, st.o[dt]);
    st.o[dt] = MFMA32(cat4(*(const bf16x4*)(bv + 32), *(const bf16x4*)(bv + 40)), pf2, st.o[dt]);
    st.o[dt] = MFMA32(cat4(*(const bf16x4*)(bv + 48), *(const bf16x4*)(bv + 56)), pf3, st.o[dt]);
  }
}

template <int PS>
DI void flash_tile(FlashState& st, const u16* sQrow, const u16* sK, const u16* sVT, float slope2,
                   int t, int tmin, int pos0, int maxdist, bool tokflag, int r, int h) {
  if (pos0 + PS * 63 <= tmin && tmin + 31 - pos0 < maxdist) {
    flash_full<PS>(st, sQrow, sK, sVT, slope2, tokflag, t - pos0, r, h);
    return;
  }
#pragma unroll
  for (int sub = 1; sub >= 0; --sub) {
    const int pfirst = pos0 + PS * 32 * sub, plast = pfirst + PS * 31;
    if (pfirst > tmin + 31 || tmin - plast >= maxdist) continue;
    const bool need_mask = (plast > tmin) || (tmin + 31 - pfirst >= maxdist);
    if (need_mask) flash_sub2<true, PS>(st, sQrow, sK, sVT, sub, slope2, tokflag, t - pfirst, maxdist, r, h);
    else flash_sub2<false, PS>(st, sQrow, sK, sVT, sub, slope2, tokflag, t - pfirst, maxdist, r, h);
  }
}

DI int prev_bit128(u64 m0, u64 m1, int start) {
  if (start >= 64) { u64 x = m1 << (127 - start); if (x) return start - __builtin_clzll(x); start = 63; }
  if (start >= 0) { u64 x = m0 << (63 - start); if (x) return start - __builtin_clzll(x); }
  return -1;
}

DI int next_bit128(u64 m0, u64 m1, int start) {
  if (start < 64) { u64 x = m0 >> start; if (x) return start + __builtin_ctzll(x); start = 64; }
  if (start < 128) { u64 x = m1 >> (start - 64); if (x) return start + __builtin_ctzll(x); }
  return 128;
}

DI void nsa_attn(const Ctx& p, int it_, char* smem) {
  const int it = __builtin_amdgcn_readfirstlane(it_);
  u16* sK = (u16*)smem;
  u16* sVT = sK + 64 * 72;
  u16* sQ = sVT + 64 * 72;
  float* sML = (float*)(sQ + 256 * 72);
  float* sImpA = sML + 512;
  float* sImpB = sImpA + 64 * 129;
  u64* sSel = (u64*)(sImpB + 64 * 129);
  u16* sK2 = (u16*)(sSel + 128);
  u16* sVT2 = sK2 + 64 * 72;
  const int tid = p.tid8, l_ = tid & 63, w = tid >> 6, r = l_ & 31, h = l_ >> 5;
  const int hw = w & 3, th = w >> 2, qrow = (th * 4 + hw) * 32 + r, tokl = th * 32 + r;
  const int bg = it & 7, tile = 127 - (it >> 3);
  const int b = bg >> 1, g = bg & 1;
  const int t0 = tile * 64, cur = tile;
  const int t = t0 + tokl;
  const int head = g * 4 + hw;
  const float slope2 = exp2f(-(float)(head + 1)) * 1.4426950408889634f;
  const int tmin = t0 + th * 32;
  u16* P = ws_P(p);
  const u16* kcG = (const u16*)(p.ws + OFF_KCG) + (size_t)(b * 2 + g) * 512 * 64;
  const u16* vcT = (const u16*)(p.ws + OFF_VCT) + (size_t)(b * 2 + g) * 64 * 512;
  const u16* vsT = (const u16*)(p.ws + OFF_VST) + (size_t)(b * 128 + g * 64) * SEQ;
  const u16* vwT = (const u16*)(p.ws + OFF_VWT) + (size_t)(b * 128 + g * 64) * SEQ;
  const size_t rowt = (size_t)b * SEQ + t;
  __syncthreads();
  const u16* sQrow = sQ + qrow * 72 + h * 8;
#pragma unroll
  for (int ks = 0; ks < 4; ++ks) {
    uint4 v = *(const uint4*)(P + rowt * PW + C_NQ + head * 64 + ks * 16 + h * 8);
    float f[8]; unpack8(v, f);
    uint4 o; o.x = pk2(f[0] * 0.125f, f[1] * 0.125f); o.y = pk2(f[2] * 0.125f, f[3] * 0.125f);
    o.z = pk2(f[4] * 0.125f, f[5] * 0.125f); o.w = pk2(f[6] * 0.125f, f[7] * 0.125f);
    *(uint4*)(sQ + qrow * 72 + ks * 16 + h * 8) = o;
  }
  const u16* gp = P + rowt * PW + C_NG + head * 3;
  const float g_cmp = sigmoidf_(bf2f(gp[0])), g_sel = sigmoidf_(bf2f(gp[1])), g_win = sigmoidf_(bf2f(gp[2]));
  for (int i = tid; i < 2 * 64 * 129; i += 512) sImpA[i] = 0.f;
  FlashState fs;
  const int nmax = (t0 + 32) >> 4;
  flash_init(fs);
  const int lrow = tid >> 3, lch = (tid & 7) * 8;
  uint4 kr, vr;
#define KV_STORE { *(uint4*)(sK + lrow * 72 + lch) = kr; *(uint4*)(sVT + lrow * 72 + lch) = vr; }
  {
    const int ntl = nmax >> 6;
    kr = *(const uint4*)(kcG + (size_t)(ntl * 64 + lrow) * 64 + lch);
    vr = *(const uint4*)(vcT + (size_t)lrow * 512 + ntl * 64 + lch);
    for (int nt = ntl; nt >= 0; --nt) {
      __syncthreads();
      KV_STORE
      __syncthreads();
      if (nt > 0) {
        kr = *(const uint4*)(kcG + (size_t)((nt - 1) * 64 + lrow) * 64 + lch);
        vr = *(const uint4*)(vcT + (size_t)lrow * 512 + (nt - 1) * 64 + lch);
      }
      flash_tile<16>(fs, sQrow, sK, sVT, slope2, t, tmin, 16 * (nt * 64) + 31, 0x40000000, true, r, h);
    }
  }
  u32 ocmp[16];
  {
    float inv = g_cmp * frcp(fmaxf(fs.l, 1e-30f));
#pragma unroll
    for (int dt = 0; dt < 2; ++dt)
#pragma unroll
      for (int gq = 0; gq < 4; ++gq) {
        ocmp[dt * 8 + 2 * gq + 0] = pk2(fs.o[dt][4 * gq + 0] * inv, fs.o[dt][4 * gq + 1] * inv);
        ocmp[dt * 8 + 2 * gq + 1] = pk2(fs.o[dt][4 * gq + 2] * inv, fs.o[dt][4 * gq + 3] * inv);
      }
    if (h == 0) { sML[qrow * 2] = fs.m; sML[qrow * 2 + 1] = fs.l; }
  }
  uint4 ir0 = *(const uint4*)(kcG + (size_t)lrow * 64 + lch), ir1 = *(const uint4*)(kcG + (size_t)(64 + lrow) * 64 + lch);
  for (int rd = 0; rd <= (nmax >> 7); ++rd) {
    __syncthreads();
    *(uint4*)(sK + lrow * 72 + lch) = ir0;
    *(uint4*)(sK + (64 + lrow) * 72 + lch) = ir1;
    __syncthreads();
    if (rd < (nmax >> 7)) {
      ir0 = *(const uint4*)(kcG + (size_t)((rd + 1) * 128 + lrow) * 64 + lch);
      ir1 = *(const uint4*)(kcG + (size_t)((rd + 1) * 128 + 64 + lrow) * 64 + lch);
    }
    const int nbase = rd * 128 + hw * 32;
    f32x16 ps = zero16();
#pragma unroll
    for (int hq = 0; hq < 4; ++hq) {
      f32x16 s = zero16();
#pragma unroll
      for (int ks = 0; ks < 4; ++ks) {
        bf16x8 a = *(const bf16x8*)(sK + (hw * 32 + r) * 72 + ks * 16 + h * 8);
        bf16x8 bq = *(const bf16x8*)(sQ + ((th * 4 + hq) * 32 + r) * 72 + ks * 16 + h * 8);
        s = MFMA32(a, bq, s);
      }
      const float mm = sML[((th * 4 + hq) * 32 + r) * 2], ll = sML[((th * 4 + hq) * 32 + r) * 2 + 1];
      const float m_use = (mm == -INFINITY) ? 0.f : mm;
      const float inv = frcp(fmaxf(ll, 1e-30f));
      const float sl = exp2f(-(float)(g * 4 + hq + 1)) * 1.4426950408889634f;
#pragma unroll
      for (int reg = 0; reg < 16; ++reg) {
        int n = nbase + crow(reg, h);
        int dist = t - (16 * n + 31);
        float pv = (dist >= 0) ? __builtin_amdgcn_exp2f(fmaf(s[reg], 1.4426950408889634f, -sl * (float)dist) - m_use) * inv : 0.f;
        ps[reg] += pv;
      }
    }
#pragma unroll
    for (int gq = 0; gq < 4; ++gq) {
      int midx = (nbase >> 2) + 2 * gq + h;
      float hb = 0.5f * ps[4 * gq + 3];
      sImpA[tokl * 129 + midx] = ps[4 * gq] + ps[4 * gq + 1] + ps[4 * gq + 2] + hb;
      if (midx + 1 < 128) sImpB[tokl * 129 + midx + 1] = hb;
    }
  }
  __syncthreads();
  {
    for (int ti = 0; ti < 8; ++ti) {
      const int tok = w * 8 + ti;
      u32 key[2];
#pragma unroll
      for (int hf = 0; hf < 2; ++hf) {
        int j = hf * 64 + l_;
        float v = sImpA[tok * 129 + j] + sImpB[tok * 129 + j];
        if (j > cur) v = -INFINITY;
        if (j == 0 || j == cur || j == cur - 1) v = INFINITY;
        u32 bits = __float_as_uint(v);
        key[hf] = (bits & 0x80000000u) ? ~bits : (bits | 0x80000000u);
      }
      u32 T = 0;
#pragma unroll 4
      for (int bit = 31; bit >= 0; --bit) {
        const u32 cand = T | (1u << bit);
        const int c = __popcll(__ballot(key[0] >= cand)) + __popcll(__ballot(key[1] >= cand));
        if (c >= 16) T = cand;
      }
      const u64 g0 = __ballot(key[0] > T), g1 = __ballot(key[1] > T);
      const u64 e0 = __ballot(key[0] == T), e1 = __ballot(key[1] == T);
      const int need = 16 - (__popcll(g0) + __popcll(g1));
      const u64 below = (1ull << l_) - 1ull;
      const int r0 = __popcll(e0 & below), r1 = __popcll(e0) + __popcll(e1 & below);
      const bool s0 = (key[0] > T) || (key[0] == T && r0 < need);
      const bool s1 = (key[1] > T) || (key[1] == T && r1 < need);
      u64 m0 = __ballot(s0 && l_ <= cur);
      u64 m1 = __ballot(s1 && (64 + l_) <= cur);
      if (l_ == 0) { sSel[tok * 2] = m0; sSel[tok * 2 + 1] = m1; }
    }
  }
  __syncthreads();
  u16* sTot = (u16*)sImpA + w * 2304;
#pragma unroll
  for (int dt = 0; dt < 2; ++dt)
#pragma unroll
    for (int gq = 0; gq < 4; ++gq) {
      uint2 ov; ov.x = ocmp[dt * 8 + 2 * gq]; ov.y = ocmp[dt * 8 + 2 * gq + 1];
      *(uint2*)(sTot + r * 72 + dt * 32 + 8 * gq + 4 * h) = ov;
    }
  const u64 my0 = sSel[tokl * 2], my1 = sSel[tokl * 2 + 1];
  u64 un0 = 0, un1 = 0;
  for (int tk = 0; tk < 64; ++tk) { un0 |= sSel[tk * 2]; un1 |= sSel[tk * 2 + 1]; }
  un0 = ((u64)__builtin_amdgcn_readfirstlane((u32)(un0 >> 32)) << 32) | (u64)__builtin_amdgcn_readfirstlane((u32)un0);
  un1 = ((u64)__builtin_amdgcn_readfirstlane((u32)(un1 >> 32)) << 32) | (u64)__builtin_amdgcn_readfirstlane((u32)un1);
  flash_init(fs);
  {
    const u16* ksrc = P + ((size_t)b * SEQ + lrow) * PW + C_KS + g * 64 + lch;
    const u16* vsrc = vsT + (size_t)lrow * SEQ + lch;
#define KV_STORE2(bb) { u16* k_ = (bb) ? sK2 : sK; u16* v_ = (bb) ? sVT2 : sVT; *(uint4*)(k_ + lrow * 72 + lch) = kr; *(uint4*)(v_ + lrow * 72 + lch) = vr; }
    int j = prev_bit128(un0, un1, cur);
    int jn = (j >= 0) ? prev_bit128(un0, un1, j - 1) : -1;
    if (j >= 0) { kr = *(const uint4*)(ksrc + (size_t)(64 * j) * PW); vr = *(const uint4*)(vsrc + 64 * j); }
    __syncthreads();
    KV_STORE2(0)
    if (jn >= 0) { kr = *(const uint4*)(ksrc + (size_t)(64 * jn) * PW); vr = *(const uint4*)(vsrc + 64 * jn); }
    __syncthreads();
    int bb = 0;
    while (j >= 0) {
      const int jnn = (jn >= 0) ? prev_bit128(un0, un1, jn - 1) : -1;
      if (jn >= 0) KV_STORE2(bb ^ 1)
      if (jnn >= 0) { kr = *(const uint4*)(ksrc + (size_t)(64 * jnn) * PW); vr = *(const uint4*)(vsrc + 64 * jnn); }
      const bool tf = (j < 64) ? ((my0 >> j) & 1) : ((my1 >> (j - 64)) & 1);
      if (__any(tf)) flash_tile<1>(fs, sQrow, bb ? sK2 : sK, bb ? sVT2 : sVT, slope2, t, tmin, 64 * j, 0x40000000, tf, r, h);
      __syncthreads();
      j = jn; jn = jnn; bb ^= 1;
    }
  }
  {
    float inv = g_sel * frcp(fmaxf(fs.l, 1e-30f));
#pragma unroll
    for (int dt = 0; dt < 2; ++dt) {
      uint2 pv[4];
#pragma unroll
      for (int gq = 0; gq < 4; ++gq) pv[gq] = *(const uint2*)(sTot + r * 72 + dt * 32 + 8 * gq + 4 * h);
#pragma unroll
      for (int gq = 0; gq < 4; ++gq) {
        uint2 ov;
        ov.x = pk2(bflo(pv[gq].x) + fs.o[dt][4 * gq + 0] * inv, bfhi(pv[gq].x) + fs.o[dt][4 * gq + 1] * inv);
        ov.y = pk2(bflo(pv[gq].y) + fs.o[dt][4 * gq + 2] * inv, bfhi(pv[gq].y) + fs.o[dt][4 * gq + 3] * inv);
        *(uint2*)(sTot + r * 72 + dt * 32 + 8 * gq + 4 * h) = ov;
      }
    }
  }
  flash_init(fs);
  {
    const int jlo = (t0 >= 511) ? ((t0 - 511) >> 6) : 0;
    const u16* ksrc = P + ((size_t)b * SEQ + lrow) * PW + C_KW + g * 64 + lch;
    const u16* vsrc = vwT + (size_t)lrow * SEQ + lch;
    kr = *(const uint4*)(ksrc + (size_t)(64 * cur) * PW); vr = *(const uint4*)(vsrc + 64 * cur);
    __syncthreads();
    KV_STORE2(0)
    if (cur - 1 >= jlo) { kr = *(const uint4*)(ksrc + (size_t)(64 * (cur - 1)) * PW); vr = *(const uint4*)(vsrc + 64 * (cur - 1)); }
    __syncthreads();
    int bb = 0;
    for (int j = cur; j >= jlo; --j) {
      if (j - 1 >= jlo) KV_STORE2(bb ^ 1)
      if (j - 2 >= jlo) { kr = *(const uint4*)(ksrc + (size_t)(64 * (j - 2)) * PW); vr = *(const uint4*)(vsrc + 64 * (j - 2)); }
      flash_tile<1>(fs, sQrow, bb ? sK2 : sK, bb ? sVT2 : sVT, slope2, t, tmin, 64 * j, 512, true, r, h);
      __syncthreads();
      bb ^= 1;
    }
  }
#undef KV_STORE2
#undef KV_STORE
  {
    float inv = g_win * frcp(fmaxf(fs.l, 1e-30f));
#pragma unroll
    for (int dt = 0; dt < 2; ++dt) {
      uint2 pv[4];
#pragma unroll
      for (int gq = 0; gq < 4; ++gq) pv[gq] = *(const uint2*)(sTot + r * 72 + dt * 32 + 8 * gq + 4 * h);
#pragma unroll
      for (int gq = 0; gq < 4; ++gq) {
        uint2 ov;
        ov.x = pk2(bflo(pv[gq].x) + fs.o[dt][4 * gq + 0] * inv, bfhi(pv[gq].x) + fs.o[dt][4 * gq + 1] * inv);
        ov.y = pk2(bflo(pv[gq].y) + fs.o[dt][4 * gq + 2] * inv, bfhi(pv[gq].y) + fs.o[dt][4 * gq + 3] * inv);
        *(uint2*)(sTot + r * 72 + dt * 32 + 8 * gq + 4 * h) = ov;
      }
    }
  }
#pragma unroll
  for (int i = 0; i < 4; ++i) {
    const int row = (l_ >> 3) + 8 * i, ch = l_ & 7;
    uint4 v = *(const uint4*)(sTot + row * 72 + ch * 8);
    *(uint4*)(P + ((size_t)b * SEQ + t0 + th * 32 + row) * PW + C_NQ + head * 64 + ch * 8) = v;
  }
}

#define VCTX int z_ = 0; asm volatile("" : "+s"(z_)); z_ = __builtin_amdgcn_readfirstlane(z_);                     \
  int t8_ = (wave_id << 6) | (int)__builtin_amdgcn_mbcnt_hi(~0u, __builtin_amdgcn_mbcnt_lo(~0u, 0u));             \
  asm volatile("" : "+v"(t8_)); const int lt_ = t8_ & 255; Ctx q{kp, kp.xf + z_, kp.ws + z_, lt_, t8_};
#define GEMM_TILES(MT, NT, CALL)                                                        \
  {                                                                                     \
    const int nsn_ = (NT) >> 1, ns_ = ((MT) >> 4) * nsn_;                               \
    const int nl_ = nb >> 3; const int xcd_ = bid / nl_, loc_ = bid - xcd_ * nl_;         \
    int sup = xcd_, wi = loc_;                                                          \
    bool primed = false;                                                                \
    GStage gst; gst.w0 = gst.w1 = gst.w2 = gst.w3 = gst.x0 = gst.x1 = gst.x2 = gst.x3 = make_uint4(0, 0, 0, 0); \
    while (sup < ns_ && wi < 32) {                                                      \
      int nsup = sup, nwi = wi + nl_;                                                   \
      if (nwi >= 32) { nwi = loc_; nsup = sup + 8; }                                    \
      const bool has_next = nsup < ns_;                                                 \
      const int sm_ = sup / nsn_, sn_ = sup - sm_ * nsn_;                               \
      const int mt = sm_ * 16 + (wi >> 1), nt = sn_ * 2 + (wi & 1);                     \
      const int smn_ = has_next ? nsup / nsn_ : sm_, snn_ = has_next ? nsup - smn_ * nsn_ : sn_; \
      const int mtn = smn_ * 16 + (nwi >> 1), ntn = snn_ * 2 + (nwi & 1);               \
      { VCTX CALL; }                                                                    \
      primed = has_next;                                                                \
      sup = nsup; wi = nwi;                                                             \
    }                                                                                   \
  }
DI void run_phase(const Params& kp, int ph, char* smem, int wave_id) {
  int bid = blockIdx.x;
  int vb = wave_id >> 2;
  asm volatile("" : "+s"(bid));
  asm volatile("" : "+s"(vb));
  bid = __builtin_amdgcn_readfirstlane(bid);
  vb = __builtin_amdgcn_readfirstlane(vb);
  const int nb = gridDim.x;
  const int vbid = bid * 2 + vb, nvb = nb * 2;
  char* vsm = smem + vb * 73728;
  if (ph == 0) {
    for (int it = vbid; it < N_CONV_TILES + 4096; it += nvb) { VCTX
      if (it < N_CONV_TILES) conv_item(q, 0, it, vsm);
      else ln_rows(q, q.kp.in[0], q.xf, ws_xb(q), q.kp.in[1], q.kp.in[2], it - N_CONV_TILES);
    }
    return;
  }
  const int l = (ph - 1) / 11, s = (ph - 1) % 11;
  switch (s) {
    case 0:
      GEMM_TILES(128, 18, ph_inproj(q, l, mt, nt, mtn, ntn, has_next, primed, gst, smem))
      break;
    case 1: {
      TilePf pf0, pf1;
      for (int it = vbid; it < 2048 + 4096 + 512 + 1024; it += nvb) { VCTX
        const int itn = it + nvb;
        if (it < 2048) hgrn_A(q, l, it, vsm, pf0, pf1, it - nvb >= 0, itn < 2048 ? itn : -1);
        else if (it < 6144) lru_item<false>(q, l, it - 2048, vsm, pf0, pf1, it - nvb >= 2048, itn < 6144 ? itn - 2048 : -1);
        else if (it < 6656) nsa_compress(q, l, it - 6144, vsm);
        else nsa_vtrans(q, it - 6656, vsm);
      }
    } break;
    case 2:
      for (int it = vbid; it < 512; it += nvb) { VCTX hgrn_B(q, it); }
      if (vbid >= nvb - 8) { VCTX lru_B(q, vbid - (nvb - 8)); }
      for (int it = bid; it < 1024; it += nb) { VCTX nsa_attn(q, it, smem); }
      break;
    case 3: {
      TilePf pf0, pf1, pf2;
      for (int it = vbid; it < 2048 + 4096; it += nvb) { VCTX
        const int itn = it + nvb;
        if (it < 2048) hgrn_C(q, l, it, vsm, pf0, pf1, pf2, it - nvb >= 0, itn < 2048 ? itn : -1);
        else lru_item<true>(q, l, it - 2048, vsm, pf0, pf1, it - nvb >= 2048, itn < 6144 ? itn - 2048 : -1);
      }
    } break;
    case 4:
      GEMM_TILES(128, 8, ph_merge(q, l, mt, nt, mtn, ntn, has_next, primed, gst, smem))
      break;
    case 5:
      GEMM_TILES(128, 4, ph_resid_gemm(q, ws_W(q) + W_OUT, 1024, ws_HS(q), 1024, 1024, mt, nt, mtn, ntn, has_next, primed, gst, smem))
      break;
    case 6:
      for (int it = vbid; it < 4096; it += nvb) { VCTX ln_rows(q, q.xf, q.xf, ws_xb(q), q.kp.in[24] + l * 1024, q.kp.in[25] + l * 1024, it); }
      break;
    case 7:
      for (int wi = bid * 8 + wave_id; wi < 704; wi += nb * 8) { VCTX ph_halo(q, wi); }
      break;
    case 8:
      GEMM_TILES(128, 22, ph_ffnup(q, l, mt, nt, mtn, ntn, has_next, primed, gst, smem))
      break;
    case 9:
      GEMM_TILES(128, 4, ph_resid_gemm(q, ws_W(q) + W_DOWN, FF, ws_P(q), FF, FF, mt, nt, mtn, ntn, has_next, primed, gst, smem))
      break;
    case 10: {
      const int nconv = (l + 1 < 2) ? N_CONV_TILES : 0;
      for (int it = vbid; it < 4096 + nconv; it += nvb) { VCTX
        if (it < 4096) ln_rows(q, q.xf, q.xf, ws_xb(q), q.kp.in[30] + l * 1024, q.kp.in[31] + l * 1024, it);
        else conv_item(q, l + 1, it - 4096, vsm);
      }
    } break;
  }
}

DI void grid_barrier(unsigned* bar, unsigned target) {
  asm volatile("s_waitcnt vmcnt(0)" ::: "memory");
  __syncthreads();
  if (threadIdx.x == 0) {
    __builtin_amdgcn_fence(__ATOMIC_RELEASE, "agent");
    asm volatile("s_waitcnt vmcnt(0)" ::: "memory");
    __hip_atomic_fetch_add(bar, 1u, __ATOMIC_RELAXED, __HIP_MEMORY_SCOPE_AGENT);
    unsigned spins = 0;
    while (__hip_atomic_load(bar, __ATOMIC_RELAXED, __HIP_MEMORY_SCOPE_AGENT) < target) {
      __builtin_amdgcn_s_sleep(1);
      if (++spins > (1u << 24)) break;
    }
    __builtin_amdgcn_fence(__ATOMIC_ACQUIRE, "agent");
    asm volatile("s_waitcnt vmcnt(0)" ::: "memory");
  }
  __syncthreads();
}

__global__ void __launch_bounds__(512, 2) mega_kernel(Params p) {
  __shared__ __attribute__((aligned(16))) char smem[SMEM_BYTES];
  cg::grid_group grid = cg::this_grid();
  unsigned nbar = 0;
  const int wave_id = __builtin_amdgcn_readfirstlane((int)(threadIdx.x >> 6));
  for (int ph = p.ph_lo; ph < p.ph_hi; ++ph) {
    run_phase(p, ph, smem, wave_id);
    if (ph + 1 < p.ph_hi) {
      if (ph == p.ph_lo) grid.sync();
      else { ++nbar; grid_barrier((unsigned*)(p.ws + OFF_BAR), nbar * gridDim.x); }
    }
  }
}

extern "C" void kernel_launch(void* const* d_in, const int* in_sizes, int n_in, void* d_out, int out_size,
                              void* d_ws, size_t ws_size, hipStream_t stream) {
  static int grid_blocks = 0;
  if (!grid_blocks) {
    int dev = 0, cus = 0, per_cu = 0;
    (void)hipGetDevice(&dev);
    (void)hipDeviceGetAttribute(&cus, hipDeviceAttributeMultiprocessorCount, dev);
    (void)hipOccupancyMaxActiveBlocksPerMultiprocessor(&per_cu, mega_kernel, 512, 0);
    if (per_cu > 1) per_cu = 1;
    if (per_cu < 1) per_cu = 1;
    grid_blocks = cus * per_cu;
    grid_blocks -= grid_blocks % 8;
  }
  (void)hipMemsetAsync((char*)d_ws + OFF_BAR, 0, 256, stream);
  Params p{};
  for (int i = 0; i < 32; ++i) p.in[i] = (const float*)d_in[i];
  p.xf = (float*)d_out;
  p.ws = (char*)d_ws;
#if MULTI_LAUNCH
  for (int ph = 0; ph < NPHASE; ++ph) {
    p.ph_lo = ph; p.ph_hi = ph + 1;
    void* args[] = {&p};
    hipError_t e = hipLaunchCooperativeKernel((void*)mega_kernel, dim3(grid_blocks), dim3(512), args, 0, stream);
    if (e != hipSuccess) fprintf(stderr, "launch failed: %s\n", hipGetErrorString(e));
  }
#else
  p.ph_lo = 0; p.ph_hi = NPHASE;
  void* args[] = {&p};
  hipError_t e = hipLaunchCooperativeKernel((void*)mega_kernel, dim3(grid_blocks), dim3(512), args, 0, stream);
  if (e != hipSuccess) fprintf(stderr, "cooperative launch failed: %s (grid %d)\n", hipGetErrorString(e), grid_blocks);
#endif
}
```
